# Optimizing an MI355X kernel written in HIP

```python
import math
import jax, jax.numpy as jnp
from jax import lax
import numpy as np

D_MODEL = 1024
BATCH = 8
SEQ = 4096
DEPTH = 2

N_EVEN = (DEPTH + 1) // 2
N_ODD = DEPTH // 2

GRID_W = 64

MLA_HEADS = 8
MLA_Q_LORA = 256
MLA_KV_LORA = 128
MLA_NOPE = 64
MLA_ROPE = 32
MLA_V = 64
MLA_QBLOCK = 128
ROPE_THETA = 10000.0

NA_HEADS = 8
NA_HEAD_DIM = 64
NA_WIN_H = 8
NA_WIN_W = 16
NA_WIDTH = NA_HEADS * NA_HEAD_DIM

RET_HEADS = 4
RET_QK_DIM = 128
RET_V_DIM = 128
RET_CHUNK = 128
RET_QK_W = RET_HEADS * RET_QK_DIM
RET_V_W = RET_HEADS * RET_V_DIM

HY_WIDTH = 512
HY_EMB_DIM = 33
HY_FILTER_HIDDEN = 64
HY_FAST_DECAY = 0.3
HY_SLOW_DECAY = 1.5
HY_TARGET = 1e-2

D_FF = 2816
SHORT_CONV = 3
EPS = 1e-6

A_IN = MLA_Q_LORA + MLA_KV_LORA + MLA_ROPE + 3 * NA_WIDTH
A_OUT = MLA_HEADS * MLA_V + NA_WIDTH
C_IN = 2 * RET_QK_W + 2 * RET_V_W + 3 * HY_WIDTH
C_OUT = RET_V_W + HY_WIDTH

kernel_name = 'hybrid_mla_natten_retnet_hyena_encoder'


def rms_norm(x, gain):
    xf = x.astype(jnp.float32)
    y = xf * lax.rsqrt(jnp.mean(xf * xf, axis=-1, keepdims=True) + EPS)
    return (y * gain.astype(jnp.float32)).astype(x.dtype)


def dwconv3(x, w):
    xp = jnp.pad(x, ((0, 0), (1, 1), (0, 0)))
    return xp[:, :-2] * w[0] + xp[:, 1:-1] * w[1] + xp[:, 2:] * w[2]


def split_cols(t, sizes):
    out, off = [], 0
    for s in sizes:
        out.append(t[..., off:off + s])
        off += s
    return out


def rope_tables(length, dim):
    inv = ROPE_THETA ** (-jnp.arange(0, dim, 2, dtype=jnp.float32) / dim)
    ang = jnp.arange(length, dtype=jnp.float32)[:, None] * inv[None, :]
    return jnp.cos(ang), jnp.sin(ang)


def apply_rope(x, cos, sin):
    shape = (1, cos.shape[0]) + (1,) * (x.ndim - 3) + (cos.shape[1],)
    c = cos.reshape(shape).astype(x.dtype)
    s = sin.reshape(shape).astype(x.dtype)
    x1, x2 = jnp.split(x, 2, axis=-1)
    return jnp.concatenate([x1 * c - x2 * s, x1 * s + x2 * c], axis=-1)


def mla_attention(cq, ckv, k_rope, q_norm, w_q_up, kv_norm, w_kv_up):
    B, S, _ = cq.shape
    q = (rms_norm(cq, q_norm) @ w_q_up).reshape(B, S, MLA_HEADS, MLA_NOPE + MLA_ROPE)
    kv = (rms_norm(ckv, kv_norm) @ w_kv_up).reshape(B, S, MLA_HEADS, MLA_NOPE + MLA_V)
    q_nope, q_rope = q[..., :MLA_NOPE], q[..., MLA_NOPE:]
    k_nope, v = kv[..., :MLA_NOPE], kv[..., MLA_NOPE:]
    cos, sin = rope_tables(S, MLA_ROPE)
    q_rope = apply_rope(q_rope, cos, sin)
    k_rope = apply_rope(k_rope, cos, sin)
    scale = (MLA_NOPE + MLA_ROPE) ** -0.5
    nb = S // MLA_QBLOCK

    def to_blocks(t):
        return jnp.moveaxis(t.reshape((B, nb, MLA_QBLOCK) + t.shape[2:]), 1, 0)

    def block(args):
        qn, qr = args
        s = (jnp.einsum('bqhd,bkhd->bhqk', qn, k_nope)
             + jnp.einsum('bqhr,bkr->bhqk', qr, k_rope))
        p = jax.nn.softmax(s.astype(jnp.float32) * scale, axis=-1).astype(v.dtype)
        return jnp.einsum('bhqk,bkhd->bqhd', p, v)

    o = lax.map(block, (to_blocks(q_nope), to_blocks(q_rope)))
    return jnp.moveaxis(o, 0, 1).reshape(B, S, MLA_HEADS * MLA_V)


def neighbourhood_attention(q, k, v, rpb):
    B, S, _ = q.shape
    rows = S // GRID_W
    kh = min(NA_WIN_H, rows)
    kw = min(NA_WIN_W, GRID_W)

    def grid(t):
        return t.reshape(B, rows, GRID_W, NA_HEADS, NA_HEAD_DIM)

    qg, kg, vg = grid(q), grid(k), grid(v)
    cols = jnp.arange(GRID_W)
    col_start = jnp.clip(cols - kw // 2, 0, GRID_W - kw)
    col_idx = col_start[:, None] + jnp.arange(kw)[None, :]
    col_off = col_idx - cols[:, None] + (NA_WIN_W - 1)
    scale = NA_HEAD_DIM ** -0.5

    def row_block(r):
        rs = jnp.clip(r - kh // 2, 0, rows - kh)
        k_rows = lax.dynamic_slice_in_dim(kg, rs, kh, axis=1)
        v_rows = lax.dynamic_slice_in_dim(vg, rs, kh, axis=1)
        k_win = k_rows[:, :, col_idx]
        v_win = v_rows[:, :, col_idx]
        q_row = lax.dynamic_index_in_dim(qg, r, axis=1, keepdims=False)
        row_off = rs + jnp.arange(kh) - r + (NA_WIN_H - 1)
        bias = jnp.transpose(rpb[:, row_off][:, :, col_off], (0, 2, 1, 3))
        s = (jnp.einsum('bchd,bicjhd->bhcij', q_row, k_win).astype(jnp.float32) * scale
             + bias.astype(jnp.float32)[None])
        p = jax.nn.softmax(s.reshape(B, NA_HEADS, GRID_W, kh * kw), axis=-1)
        p = p.reshape(s.shape).astype(v.dtype)
        return jnp.einsum('bhcij,bicjhd->bchd', p, v_win)

    o = lax.map(row_block, jnp.arange(rows))
    return jnp.moveaxis(o, 0, 1).reshape(B, S, NA_WIDTH)


def retention_scan(q, k, v, log_g, strict):
    B, H, S, dk = q.shape
    dv = v.shape[-1]
    C = RET_CHUNK
    n = S // C
    j = jnp.arange(C, dtype=jnp.float32)
    diff = j[:, None] - j[None, :]
    mask = (diff > 0) if strict else (diff >= 0)
    dmat = jnp.where(mask[None], jnp.exp(jnp.where(mask, diff, 0.0)[None] * log_g[:, None, None]),
                     0.0).astype(q.dtype)
    xi = jnp.exp((j + 1.0)[None] * log_g[:, None]).astype(q.dtype)
    zeta = jnp.exp((C - 1.0 - j)[None] * log_g[:, None]).astype(q.dtype)
    g_chunk = jnp.exp(C * log_g).astype(q.dtype)
    qc = q.reshape(B, H, n, C, dk)
    kc = k.reshape(B, H, n, C, dk)
    vc = v.reshape(B, H, n, C, dv)
    scores = jnp.einsum('bhncd,bhnmd->bhncm', qc, kc) * dmat[None, :, None]
    o_intra = jnp.einsum('bhncm,bhnme->bhnce', scores, vc)
    kv_chunk = jnp.einsum('bhncd,bhnce->bhnde', kc * zeta[None, :, None, :, None], vc)

    def step(state, kv_n):
        return g_chunk[None, :, None, None] * state + kv_n, state

    _, states = lax.scan(step, jnp.zeros((B, H, dk, dv), q.dtype), jnp.moveaxis(kv_chunk, 2, 0))
    states = jnp.moveaxis(states, 0, 2)
    o_cross = jnp.einsum('bhncd,bhnde->bhnce', qc, states) * xi[None, :, None, :, None]
    return (o_intra + o_cross).reshape(B, H, S, dv)


def bidirectional_retention(rq, rk, rv, rg, decay_fwd, decay_bwd):
    B, S, _ = rq.shape
    cos, sin = rope_tables(S, RET_QK_DIM)
    q = apply_rope(rq.reshape(B, S, RET_HEADS, RET_QK_DIM), cos, sin)
    k = apply_rope(rk.reshape(B, S, RET_HEADS, RET_QK_DIM), cos, sin) * (RET_QK_DIM ** -0.5)
    q = jnp.transpose(q, (0, 2, 1, 3))
    k = jnp.transpose(k, (0, 2, 1, 3))
    v = jnp.transpose(rv.reshape(B, S, RET_HEADS, RET_V_DIM), (0, 2, 1, 3))
    log_f = jax.nn.log_sigmoid(decay_fwd.astype(jnp.float32))
    log_b = jax.nn.log_sigmoid(decay_bwd.astype(jnp.float32))
    o_f = retention_scan(q, k, v, log_f, False)
    o_b = retention_scan(q[:, :, ::-1], k[:, :, ::-1], v[:, :, ::-1], log_b, True)[:, :, ::-1]
    o = jnp.transpose(o_f + o_b, (0, 2, 1, 3)).astype(jnp.float32)
    o = (o * lax.rsqrt(jnp.mean(o * o, axis=-1, keepdims=True) + EPS)).astype(rv.dtype)
    gate = jax.nn.silu(rg.reshape(B, S, RET_HEADS, RET_V_DIM))
    return (o * gate).reshape(B, S, RET_V_W)


def hyena_filters(length, w1, b1, w2, b2, w3, b3, w4, freq):
    t = jnp.arange(length, dtype=jnp.float32) / (length - 1)
    bands = (HY_EMB_DIM - 1) // 2
    w = 2.0 * math.pi * jnp.arange(length, dtype=jnp.float32) / length
    f = jnp.linspace(1e-4, bands - 1, bands, dtype=jnp.float32)
    fw = f[None, :] * w[:, None]
    z = jnp.concatenate([t[:, None], jnp.cos(fw), -jnp.sin(fw)], axis=-1).astype(w1.dtype)
    h = jnp.sin(freq * (z @ w1 + b1))
    h = jnp.sin(freq * (h @ w2 + b2))
    h = jnp.sin(freq * (h @ w3 + b3))
    h = h @ w4
    max_decay = math.log(HY_TARGET) / HY_FAST_DECAY
    min_decay = math.log(HY_TARGET) / HY_SLOW_DECAY
    deltas = jnp.linspace(min_decay, max_decay, HY_WIDTH, dtype=jnp.float32)
    window = jnp.exp(-t[:, None] * jnp.abs(deltas)[None, :]).astype(h.dtype)
    return h[:, :HY_WIDTH] * window, h[:, HY_WIDTH:] * window


def hyena_operator(u_proj, short_conv, w1, b1, w2, b2, w3, b3, w4, freq, hy_bias):
    B, L, _ = u_proj.shape
    z = dwconv3(u_proj, short_conv)
    x0, x1, v = jnp.split(z, 3, axis=-1)
    h_f, h_b = hyena_filters(L, w1, b1, w2, b2, w3, b3, w4, freq)
    k_circ = jnp.concatenate([h_f, jnp.zeros((1, HY_WIDTH), h_f.dtype), h_b[1:][::-1]],
                             axis=0).astype(jnp.float32)
    u = v * x1
    uf = jnp.fft.rfft(u.astype(jnp.float32), n=2 * L, axis=1)
    kf = jnp.fft.rfft(k_circ, n=2 * L, axis=0)
    y = jnp.fft.irfft(uf * kf[None], n=2 * L, axis=1)[:, :L].astype(u.dtype)
    y = y + u * hy_bias
    return y * x0


def even_mixer(h, w_in, q_norm, w_q_up, kv_norm, w_kv_up, rpb, w_out):
    cq, ckv, k_rope, nq, nk, nv = split_cols(
        h @ w_in, [MLA_Q_LORA, MLA_KV_LORA, MLA_ROPE, NA_WIDTH, NA_WIDTH, NA_WIDTH])
    a = mla_attention(cq, ckv, k_rope, q_norm, w_q_up, kv_norm, w_kv_up)
    b = neighbourhood_attention(nq, nk, nv, rpb)
    return jnp.concatenate([a, b], axis=-1) @ w_out


def odd_mixer(h, w_in, decay_fwd, decay_bwd, short_conv, w1, b1, w2, b2, w3, b3, w4, freq,
              hy_bias, w_out):
    rq, rk, rv, rg, hy = split_cols(h @ w_in, [RET_QK_W, RET_QK_W, RET_V_W, RET_V_W, 3 * HY_WIDTH])
    c = bidirectional_retention(rq, rk, rv, rg, decay_fwd, decay_bwd)
    d = hyena_operator(hy, short_conv, w1, b1, w2, b2, w3, b3, w4, freq, hy_bias)
    return jnp.concatenate([c, d], axis=-1) @ w_out


def conv_ffn(h, w_gate, w_up, conv_w, w_down):
    g = dwconv3(h @ w_gate, conv_w)
    return (jax.nn.gelu(g, approximate=True) * (h @ w_up)) @ w_down


def setup_inputs(seed: int = 0) -> dict:
    key = jax.random.key(seed)
    ks = iter(jax.random.split(key, 48))

    def nrm(shape, scale):
        return jax.random.normal(next(ks), shape, jnp.float32) * scale

    def gain(shape):
        return 1.0 + nrm(shape, 0.01)

    ret_decay_init = jnp.log(2.0 ** (5.0 + jnp.arange(RET_HEADS, dtype=jnp.float32)) - 1.0)
    return {
        'x': nrm((BATCH, SEQ, D_MODEL), 1.0),
        'mix_pre_norm': gain((DEPTH, D_MODEL)),
        'mix_post_norm': gain((DEPTH, D_MODEL)),
        'ffn_pre_norm': gain((DEPTH, D_MODEL)),
        'ffn_post_norm': gain((DEPTH, D_MODEL)),
        'ffn_w_gate': nrm((DEPTH, D_MODEL, D_FF), D_MODEL ** -0.5),
        'ffn_w_up': nrm((DEPTH, D_MODEL, D_FF), D_MODEL ** -0.5),
        'ffn_conv': nrm((DEPTH, SHORT_CONV, D_FF), SHORT_CONV ** -0.5),
        'ffn_w_down': nrm((DEPTH, D_FF, D_MODEL), D_FF ** -0.5),
        'a_w_in': nrm((N_EVEN, D_MODEL, A_IN), D_MODEL ** -0.5),
        'a_q_norm': gain((N_EVEN, MLA_Q_LORA)),
        'a_w_q_up': nrm((N_EVEN, MLA_Q_LORA, MLA_HEADS * (MLA_NOPE + MLA_ROPE)), MLA_Q_LORA ** -0.5),
        'a_kv_norm': gain((N_EVEN, MLA_KV_LORA)),
        'a_w_kv_up': nrm((N_EVEN, MLA_KV_LORA, MLA_HEADS * (MLA_NOPE + MLA_V)), MLA_KV_LORA ** -0.5),
        'a_rpb': nrm((N_EVEN, NA_HEADS, 2 * NA_WIN_H - 1, 2 * NA_WIN_W - 1), 0.1),
        'a_w_out': nrm((N_EVEN, A_OUT, D_MODEL), A_OUT ** -0.5),
        'c_w_in': nrm((N_ODD, D_MODEL, C_IN), D_MODEL ** -0.5),
        'c_decay_fwd': ret_decay_init[None] + nrm((N_ODD, RET_HEADS), 0.1),
        'c_decay_bwd': ret_decay_init[None] + nrm((N_ODD, RET_HEADS), 0.1),
        'c_short_conv': nrm((N_ODD, SHORT_CONV, 3 * HY_WIDTH), SHORT_CONV ** -0.5),
        'c_filt_w1': nrm((N_ODD, HY_EMB_DIM, HY_FILTER_HIDDEN), HY_EMB_DIM ** -0.5),
        'c_filt_b1': nrm((N_ODD, HY_FILTER_HIDDEN), 0.02),
        'c_filt_w2': nrm((N_ODD, HY_FILTER_HIDDEN, HY_FILTER_HIDDEN), HY_FILTER_HIDDEN ** -0.5),
        'c_filt_b2': nrm((N_ODD, HY_FILTER_HIDDEN), 0.02),
        'c_filt_w3': nrm((N_ODD, HY_FILTER_HIDDEN, HY_FILTER_HIDDEN), HY_FILTER_HIDDEN ** -0.5),
        'c_filt_b3': nrm((N_ODD, HY_FILTER_HIDDEN), 0.02),
        'c_filt_w4': nrm((N_ODD, HY_FILTER_HIDDEN, 2 * HY_WIDTH), 0.1 * HY_FILTER_HIDDEN ** -0.5),
        'c_filt_freq': gain((N_ODD, HY_FILTER_HIDDEN)),
        'c_hy_bias': nrm((N_ODD, HY_WIDTH), 1.0),
        'c_w_out': nrm((N_ODD, C_OUT, D_MODEL), C_OUT ** -0.5),
    }


def reference(x, mix_pre_norm, mix_post_norm, ffn_pre_norm, ffn_post_norm, ffn_w_gate, ffn_w_up,
              ffn_conv, ffn_w_down, a_w_in, a_q_norm, a_w_q_up, a_kv_norm, a_w_kv_up, a_rpb, a_w_out,
              c_w_in, c_decay_fwd, c_decay_bwd, c_short_conv, c_filt_w1, c_filt_b1, c_filt_w2,
              c_filt_b2, c_filt_w3, c_filt_b3, c_filt_w4, c_filt_freq, c_hy_bias, c_w_out):
    for layer in range(DEPTH):
        i = layer // 2
        h = rms_norm(x, mix_pre_norm[layer])
        if layer % 2 == 0:
            m = even_mixer(h, a_w_in[i], a_q_norm[i], a_w_q_up[i], a_kv_norm[i], a_w_kv_up[i],
                           a_rpb[i], a_w_out[i])
        else:
            m = odd_mixer(h, c_w_in[i], c_decay_fwd[i], c_decay_bwd[i], c_short_conv[i],
                          c_filt_w1[i], c_filt_b1[i], c_filt_w2[i], c_filt_b2[i], c_filt_w3[i],
                          c_filt_b3[i], c_filt_w4[i], c_filt_freq[i], c_hy_bias[i], c_w_out[i])
        x = x + rms_norm(m, mix_post_norm[layer])
        h = rms_norm(x, ffn_pre_norm[layer])
        f = conv_ffn(h, ffn_w_gate[layer], ffn_w_up[layer], ffn_conv[layer], ffn_w_down[layer])
        x = x + rms_norm(f, ffn_post_norm[layer])
    return x
```

```cpp
#include <hip/hip_runtime.h>
#include <hip/hip_cooperative_groups.h>
#include <stdint.h>
#include <stdio.h>
namespace cg = cooperative_groups;

#ifndef DUP_MASK
#define DUP_MASK 0u
#endif
#ifndef DUP_SYNC
#define DUP_SYNC 0
#endif
#ifndef MEGA
#define MEGA 1
#endif

#define DI __device__ __forceinline__
typedef unsigned short bf16_t;
typedef __attribute__((ext_vector_type(8))) short bf16x8;
typedef __attribute__((ext_vector_type(16))) float f32x16;
typedef __attribute__((ext_vector_type(4))) float f32x4;
typedef __attribute__((ext_vector_type(4))) unsigned u32x4;
typedef __attribute__((ext_vector_type(2))) unsigned u32x2;
typedef __bf16 bf2_t __attribute__((ext_vector_type(2)));
typedef float f2_t __attribute__((ext_vector_type(2)));

#define MFMA32(a, b, c) __builtin_amdgcn_mfma_f32_32x32x16_bf16(__builtin_bit_cast(bf16x8, (a)), __builtin_bit_cast(bf16x8, (b)), (c), 0, 0, 0)
#define MFMA16(a, b, c) __builtin_amdgcn_mfma_f32_16x16x32_bf16(__builtin_bit_cast(bf16x8, (a)), __builtin_bit_cast(bf16x8, (b)), (c), 0, 0, 0)

constexpr int T = 32768, S = 4096, NBATCH = 8, DM = 1024, DFF = 2816;
constexpr float EPS = 1e-6f;
constexpr float LOG2E = 1.4426950408889634f;

DI int threadIdx_x_raw() { return (int)__builtin_amdgcn_workitem_id_x(); }
DI unsigned pack2(float a, float b) { f2_t f = {a, b}; bf2_t r = __builtin_convertvector(f, bf2_t); return __builtin_bit_cast(unsigned, r); }
DI float bflo(unsigned u) { return __uint_as_float(u << 16); }
DI float bfhi(unsigned u) { return __uint_as_float(u & 0xffff0000u); }
DI float bf2f(bf16_t v) { return __uint_as_float(((unsigned)v) << 16); }
DI bf16_t f2bf(float x) { return (bf16_t)(pack2(x, 0.f) & 0xffffu); }
DI float ex2(float x) { return __builtin_amdgcn_exp2f(x); }
DI int tid512() { int t = threadIdx_x_raw(); asm volatile("" : "+v"(t)); return t; }
DI int tidx() { return tid512() & 255; }
DI int vhalf() { return __builtin_amdgcn_readfirstlane(threadIdx_x_raw() >> 8); }
DI int vbid() { return 2 * (int)blockIdx.x + vhalf(); }
DI int vgrid() { return 2 * (int)gridDim.x; }
DI int crow(int reg, int h) { return (reg & 3) + 8 * (reg >> 2) + 4 * h; }
DI u32x4 ldg16(const void* p) { return *(const u32x4*)p; }
DI u32x4 zero4() { u32x4 z = {0u, 0u, 0u, 0u}; return z; }
DI int clampi(int v, int lo, int hi) { return v < lo ? lo : (v > hi ? hi : v); }

constexpr size_t SZ_WT_IN0 = (size_t)1952 * 1024 * 2, SZ_WT_QUP = (size_t)768 * 256 * 2, SZ_WT_KVUP = (size_t)1024 * 128 * 2,
                 SZ_WT_SQ = (size_t)1024 * 1024 * 2, SZ_WT_GU = (size_t)5632 * 1024 * 2, SZ_WT_DOWN = (size_t)1024 * 2816 * 2,
                 SZ_WT_IN1 = (size_t)3584 * 1024 * 2, SZ_ROPEA = (size_t)4096 * 16 * 8, SZ_ROPER = (size_t)4096 * 64 * 8,
                 SZ_FILT = (size_t)512 * 8192 * 2;
constexpr size_t OFF_WT_IN0 = 0;
constexpr size_t OFF_WT_QUP = OFF_WT_IN0 + SZ_WT_IN0;
constexpr size_t OFF_WT_KVUP = OFF_WT_QUP + SZ_WT_QUP;
constexpr size_t OFF_WT_OUT0 = OFF_WT_KVUP + SZ_WT_KVUP;
constexpr size_t OFF_WT_GU0 = OFF_WT_OUT0 + SZ_WT_SQ;
constexpr size_t OFF_WT_GU1 = OFF_WT_GU0 + SZ_WT_GU;
constexpr size_t OFF_WT_DN0 = OFF_WT_GU1 + SZ_WT_GU;
constexpr size_t OFF_WT_DN1 = OFF_WT_DN0 + SZ_WT_DOWN;
constexpr size_t OFF_WT_IN1 = OFF_WT_DN1 + SZ_WT_DOWN;
constexpr size_t OFF_WT_OUT1 = OFF_WT_IN1 + SZ_WT_IN1;
constexpr size_t OFF_ROPEA = OFF_WT_OUT1 + SZ_WT_SQ;
constexpr size_t OFF_ROPER = OFF_ROPEA + SZ_ROPEA;
constexpr size_t OFF_FILT = OFF_ROPER + SZ_ROPER;
constexpr size_t OFF_H = OFF_FILT + SZ_FILT;
constexpr size_t SZ_H = (size_t)T * 1024 * 2;
constexpr size_t OFF_AB = OFF_H + SZ_H;
constexpr size_t OFF_R = OFF_AB + SZ_H;
constexpr size_t OFF_P = OFF_R;
constexpr size_t OFF_QM = OFF_P + (size_t)T * 1952 * 2;
constexpr size_t OFF_KF = OFF_QM + (size_t)T * 768 * 2;
constexpr size_t OFF_VTM = OFF_KF + (size_t)T * 768 * 2;
constexpr size_t OFF_VTN = OFF_VTM + (size_t)T * 512 * 2;
constexpr size_t END_L0 = OFF_VTN + (size_t)T * 512 * 2;
constexpr size_t OFF_HID = OFF_R;
constexpr size_t OFF_M = OFF_R + (size_t)T * 2816 * 2;
constexpr size_t END_FFN = OFF_M + SZ_H;
constexpr size_t OFF_RQ = OFF_R;
constexpr size_t OFF_RK = OFF_RQ + (size_t)T * 512 * 2;
constexpr size_t OFF_RKT = OFF_RK + (size_t)T * 512 * 2;
constexpr size_t OFF_RVT = OFF_RKT + (size_t)T * 512 * 2;
constexpr size_t OFF_RG = OFF_RVT + (size_t)T * 512 * 2;
constexpr size_t OFF_HY = OFF_RG + (size_t)T * 512 * 2;
constexpr size_t OFF_KVF = OFF_HY + (size_t)T * 1536 * 2;
constexpr size_t OFF_KVB = OFF_KVF + (size_t)1024 * 16384 * 2;
constexpr size_t END_L1 = OFF_KVB + (size_t)1024 * 16384 * 2;
constexpr size_t HB_UT = 0;
constexpr size_t HB_YT = (size_t)512 * 8 * 4096 * 2;
constexpr size_t WS_NEED = END_L1 > END_L0 ? (END_L1 > END_FFN ? END_L1 : END_FFN) : (END_L0 > END_FFN ? END_L0 : END_FFN);
constexpr size_t OFF_BAR = (WS_NEED + 255) & ~(size_t)255;
constexpr size_t BAR_BYTES = 64 * 256;
static_assert(OFF_BAR + BAR_BYTES <= (size_t)512 * 1024 * 1024, "workspace too large");

struct Params {
  const float *x, *mix_pre, *mix_post, *ffn_pre, *ffn_post, *w_gate, *w_up, *ffn_conv, *w_down;
  const float *a_w_in, *a_q_norm, *a_w_q_up, *a_kv_norm, *a_w_kv_up, *a_rpb, *a_w_out;
  const float *c_w_in, *c_decay_f, *c_decay_b, *c_short, *f_w1, *f_b1, *f_w2, *f_b2, *f_w3, *f_b3, *f_w4, *f_freq, *hy_bias, *c_w_out;
  float* out;
  char* ws;
  char* hbuf;
};

constexpr int SMEM_BYTES = 73728;

constexpr int GLD = 72;
constexpr int CLD = 132;
template <class AL, class BL, class EP>
DI void gemm_tile(AL al, BL bl, EP ep, int K, char* smem) {
  bf16_t* sA = (bf16_t*)smem;
  bf16_t* sB = sA + 2 * 128 * GLD;
  const int tid = tidx(), lane = tid & 63, w = tid >> 6, wm = w >> 1, wn = w & 1, r = lane & 31, h = lane >> 5;
  const int lrow = tid >> 3, lck = tid & 7;
  f32x16 acc[2][2];
#pragma unroll
  for (int i = 0; i < 2; ++i)
#pragma unroll
    for (int j = 0; j < 2; ++j)
#pragma unroll
      for (int q = 0; q < 16; ++q) acc[i][j][q] = 0.f;
  u32x4 ra0[4], rb0[4], ra1[4], rb1[4];
  const int KT = K >> 6;
#define G_LOAD(RA, RB, kt_) { _Pragma("unroll") for (int i = 0; i < 4; ++i) { RA[i] = al(lrow + 32 * i, (kt_) * 64 + lck * 8); RB[i] = bl(lrow + 32 * i, (kt_) * 64 + lck * 8); } }
#define G_STORE(RA, RB, buf_) { bf16_t* nA = sA + (buf_) * 128 * GLD; bf16_t* nB = sB + (buf_) * 128 * GLD; _Pragma("unroll") for (int i = 0; i < 4; ++i) { \
      *(u32x4*)(nA + (lrow + 32 * i) * GLD + lck * 8) = RA[i]; *(u32x4*)(nB + (lrow + 32 * i) * GLD + lck * 8) = RB[i]; } }
#define G_COMPUTE(buf_) { const bf16_t* cA = sA + (buf_) * 128 * GLD + (64 * wm + r) * GLD + 8 * h; const bf16_t* cB = sB + (buf_) * 128 * GLD + (64 * wn + r) * GLD + 8 * h; \
    _Pragma("unroll") for (int ks = 0; ks < 4; ++ks) { \
      u32x4 a0 = *(const u32x4*)(cA + ks * 16); u32x4 a1 = *(const u32x4*)(cA + 32 * GLD + ks * 16); \
      u32x4 b0 = *(const u32x4*)(cB + ks * 16); u32x4 b1 = *(const u32x4*)(cB + 32 * GLD + ks * 16); \
      acc[0][0] = MFMA32(a0, b0, acc[0][0]); acc[0][1] = MFMA32(a0, b1, acc[0][1]); \
      acc[1][0] = MFMA32(a1, b0, acc[1][0]); acc[1][1] = MFMA32(a1, b1, acc[1][1]); } }
  G_LOAD(ra0, rb0, 0);
  if (KT > 1) G_LOAD(ra1, rb1, 1);
  __syncthreads();
  G_STORE(ra0, rb0, 0);
  __syncthreads();
  for (int kt = 0; kt < KT; kt += 2) {
    if (kt + 2 < KT) G_LOAD(ra0, rb0, kt + 2);
    __builtin_amdgcn_sched_barrier(0);
    G_COMPUTE(0);
    __builtin_amdgcn_sched_barrier(0);
    if (kt + 1 < KT) G_STORE(ra1, rb1, 1);
    __syncthreads();
    if (kt + 1 >= KT) break;
    if (kt + 3 < KT) G_LOAD(ra1, rb1, kt + 3);
    __builtin_amdgcn_sched_barrier(0);
    G_COMPUTE(1);
    __builtin_amdgcn_sched_barrier(0);
    if (kt + 2 < KT) G_STORE(ra0, rb0, 0);
    __syncthreads();
  }
#undef G_LOAD
#undef G_STORE
#undef G_COMPUTE
  float* sC = (float*)smem;
#pragma unroll
  for (int i = 0; i < 2; ++i)
#pragma unroll
    for (int j = 0; j < 2; ++j)
#pragma unroll
      for (int q = 0; q < 16; ++q) sC[(64 * wm + 32 * i + crow(q, h)) * CLD + 64 * wn + 32 * j + r] = acc[i][j][q];
  __syncthreads();
  ep(sC);
}

struct Sched { int xs, nx, rank, minloc; };
DI int sched_tile(const Sched& sc, int round, int MT, int NT, int& mt, int& nt) {
  const int total = MT * NT;
  const int per = (total + sc.nx - 1) / sc.nx;
  const int off = round * sc.minloc;
  if (off >= per) return 2;
  if (sc.rank >= sc.minloc) return 1;
  int L = off + sc.rank;
  if (L >= per) return 1;
  L += sc.xs * per;
  if (L >= total) return 1;
  for (int c0 = 0; c0 < NT; c0 += 8) {
    const int w = NT - c0 < 8 ? NT - c0 : 8;
    const int cnt = MT * w;
    if (L < cnt) { mt = L / w; nt = c0 + L - mt * w; return 0; }
    L -= cnt;
  }
  return 1;
}

constexpr int BLD = 264;
constexpr int SMEM_HALF = 73728;
constexpr int SMEM_TOTAL = 2 * SMEM_HALF;
template <class AL, class BL, class EP>
DI void gemm_tile256(AL al, BL bl, EP ep, int K, char* smem) {
  bf16_t* sA = (bf16_t*)smem;
  bf16_t* sB = sA + 2 * 256 * GLD;
  const int tid = tid512(), lane = tid & 63, w = tid >> 6, wm = w >> 2, wn = w & 3, r = lane & 31, h = lane >> 5;
  const int lrow = tid >> 3, lck = tid & 7;
  f32x16 acc[4][2];
#pragma unroll
  for (int i = 0; i < 4; ++i)
#pragma unroll
    for (int j = 0; j < 2; ++j)
#pragma unroll
      for (int q = 0; q < 16; ++q) acc[i][j][q] = 0.f;
  u32x4 ra[4], rb[4];
  const int KT = K >> 6;
#define G_LOADA(kt_) { _Pragma("unroll") for (int i = 0; i < 4; ++i) ra[i] = al(lrow + 64 * i, (kt_) * 64 + lck * 8); }
#define G_LOADB(kt_) { _Pragma("unroll") for (int i = 0; i < 4; ++i) rb[i] = bl(lrow + 64 * i, (kt_) * 64 + lck * 8); }
#define G_STOREA(buf_) { bf16_t* nA = sA + (buf_) * 256 * GLD; _Pragma("unroll") for (int i = 0; i < 4; ++i) *(u32x4*)(nA + (lrow + 64 * i) * GLD + lck * 8) = ra[i]; }
#define G_STOREB(buf_) { bf16_t* nB = sB + (buf_) * 256 * GLD; _Pragma("unroll") for (int i = 0; i < 4; ++i) *(u32x4*)(nB + (lrow + 64 * i) * GLD + lck * 8) = rb[i]; }
#define G_COMPUTE_KS(buf_, ks) { const bf16_t* cA = sA + (buf_) * 256 * GLD + (128 * wm + r) * GLD + 8 * h; const bf16_t* cB = sB + (buf_) * 256 * GLD + (64 * wn + r) * GLD + 8 * h; \
      u32x4 b0 = *(const u32x4*)(cB + (ks) * 16); u32x4 b1 = *(const u32x4*)(cB + 32 * GLD + (ks) * 16); \
      _Pragma("unroll") for (int i = 0; i < 4; ++i) { u32x4 a = *(const u32x4*)(cA + 32 * i * GLD + (ks) * 16); \
        acc[i][0] = MFMA32(b0, a, acc[i][0]); acc[i][1] = MFMA32(b1, a, acc[i][1]); } }
#define G_STEP(cur_, kt_) { \
    if ((kt_) + 1 < KT) G_LOADA((kt_) + 1); \
    __builtin_amdgcn_sched_barrier(0); \
    G_COMPUTE_KS(cur_, 0); \
    __builtin_amdgcn_sched_barrier(0); \
    if ((kt_) + 1 < KT) G_STOREB((cur_) ^ 1); \
    if ((kt_) + 2 < KT) G_LOADB((kt_) + 2); \
    __builtin_amdgcn_sched_barrier(0); \
    G_COMPUTE_KS(cur_, 1); G_COMPUTE_KS(cur_, 2); \
    __builtin_amdgcn_sched_barrier(0); \
    if ((kt_) + 1 < KT) G_STOREA((cur_) ^ 1); \
    __builtin_amdgcn_sched_barrier(0); \
    G_COMPUTE_KS(cur_, 3); \
    __syncthreads(); }
  G_LOADA(0); G_LOADB(0);
  __syncthreads();
  G_STOREA(0); G_STOREB(0);
  if (KT > 1) G_LOADB(1);
  __syncthreads();
  for (int kt = 0; kt < KT; kt += 2) {
    G_STEP(0, kt);
    if (kt + 1 >= KT) break;
    G_STEP(1, kt + 1);
  }
#undef G_LOADA
#undef G_LOADB
#undef G_STOREA
#undef G_STOREB
#undef G_COMPUTE_KS
#undef G_STEP
  if constexpr (EP::kBf16) {
    bf16_t* sCb = (bf16_t*)smem;
#pragma unroll
    for (int i = 0; i < 4; ++i)
#pragma unroll
      for (int j = 0; j < 2; ++j)
#pragma unroll
        for (int g = 0; g < 4; ++g) {
          u32x2 v = {pack2(acc[i][j][4 * g], acc[i][j][4 * g + 1]), pack2(acc[i][j][4 * g + 2], acc[i][j][4 * g + 3])};
          *(u32x2*)(sCb + (128 * wm + 32 * i + r) * BLD + 64 * wn + 32 * j + 8 * g + 4 * h) = v;
        }
    __syncthreads();
    ep(sCb);
  } else {
    float* sC = (float*)smem;
#pragma unroll
    for (int pass = 0; pass < 2; ++pass) {
      if (pass) __syncthreads();
      if ((wn >> 1) == pass) {
#pragma unroll
        for (int i = 0; i < 4; ++i)
#pragma unroll
          for (int j = 0; j < 2; ++j)
#pragma unroll
            for (int g = 0; g < 4; ++g) {
              f32x4 v = {acc[i][j][4 * g], acc[i][j][4 * g + 1], acc[i][j][4 * g + 2], acc[i][j][4 * g + 3]};
              *(f32x4*)(sC + (128 * wm + 32 * i + r) * CLD + 64 * (wn & 1) + 32 * j + 8 * g + 4 * h) = v;
            }
      }
      __syncthreads();
      ep(sC, pass);
    }
  }
}

struct LoadRows {
  const bf16_t* base; int ld; int row0; int nrows;
  DI u32x4 operator()(int r, int k) const {
    int row = row0 + r;
    row = row < nrows ? row : nrows - 1;
    return ldg16(base + (size_t)row * ld + k);
  }
};

DI void store8(bf16_t* dst, const float* v) {
  u32x4 o; o[0] = pack2(v[0], v[1]); o[1] = pack2(v[2], v[3]); o[2] = pack2(v[4], v[5]); o[3] = pack2(v[6], v[7]);
  *(u32x4*)dst = o;
}
DI void ld8f(const float* s, float* v) {
  f32x4 a = *(const f32x4*)s, b = *(const f32x4*)(s + 4);
  v[0] = a[0]; v[1] = a[1]; v[2] = a[2]; v[3] = a[3]; v[4] = b[0]; v[5] = b[1]; v[6] = b[2]; v[7] = b[3];
}

DI void ld8b(const bf16_t* p, float* v) {
  u32x4 u = *(const u32x4*)p;
#pragma unroll
  for (int q = 0; q < 4; ++q) { v[2 * q] = bflo(u[q]); v[2 * q + 1] = bfhi(u[q]); }
}
struct EpStore {
  bf16_t* dst; int ld; int m0; int n0; int N;
  DI void operator()(const float* sC) const {
    for (int id = tidx(); id < 2048; id += 256) {
      int row = id >> 4, c8 = (id & 15) * 8;
      if (n0 + c8 < N) { float v[8]; ld8f(sC + row * CLD + c8, v); store8(dst + (size_t)(m0 + row) * ld + n0 + c8, v); }
    }
  }
};

DI void transpose_tile(const float* __restrict__ src, bf16_t* __restrict__ dst, int K, int N, const float* kscale, int mode, int tile, char* smem) {
  float* sm = (float*)smem;
  const int ntn = (N + 63) >> 6;
  const int tk = tile / ntn, tn = tile - tk * ntn, k0 = tk * 64, n0 = tn * 64, tid = tidx();
  __syncthreads();
#pragma unroll 4
  for (int i = 0; i < 16; ++i) {
    int k = (tid >> 6) + 4 * i, n = n0 + (tid & 63);
    float v = (n < N) ? src[(size_t)(k0 + k) * N + n] : 0.f;
    if (kscale) v *= kscale[k0 + k];
    sm[k * 65 + (tid & 63)] = v;
  }
  __syncthreads();
#pragma unroll
  for (int i = 0; i < 2; ++i) {
    int nl = (tid >> 3) + 32 * i, n = n0 + nl, kc = (tid & 7) * 8;
    if (n < N) {
      float v[8];
#pragma unroll
      for (int j = 0; j < 8; ++j) v[j] = sm[(kc + j) * 65 + nl];
      int drow = n;
      if (mode == 1) drow = (n >> 6) * 128 + (n & 63);
      if (mode == 2) drow = (n >> 6) * 128 + 64 + (n & 63);
      store8(dst + (size_t)drow * K + k0 + kc, v);
    }
  }
}

DI void rms_row_to_bf16(const float* __restrict__ xr, const float* __restrict__ g, bf16_t* __restrict__ hr, int lane) {
  f32x4 v[4]; float ss = 0.f;
#pragma unroll
  for (int i = 0; i < 4; ++i) { v[i] = *(const f32x4*)(xr + lane * 4 + 256 * i);     ss += v[i][0] * v[i][0] + v[i][1] * v[i][1] + v[i][2] * v[i][2] + v[i][3] * v[i][3]; }
#pragma unroll
  for (int o = 32; o >= 1; o >>= 1) ss += __shfl_xor(ss, o);
  float rs = rsqrtf(ss * (1.f / 1024.f) + EPS);
#pragma unroll
  for (int i = 0; i < 4; ++i) {
    f32x4 gg = *(const f32x4*)(g + lane * 4 + 256 * i);
    u32x2 o; o[0] = pack2(v[i][0] * rs * gg[0], v[i][1] * rs * gg[1]); o[1] = pack2(v[i][2] * rs * gg[2], v[i][3] * rs * gg[3]);
    *(u32x2*)(hr + lane * 4 + 256 * i) = o;
  }
}

DI void sincos_acc(float ang, float& c, float& s) {
  double a = (double)ang;
  double n = rint(a * 0.15915494309189535);
  float r = (float)(a - n * 6.283185307179586);
  c = cosf(r); s = sinf(r);
}

DI void hyena_filter_pos(const Params& p, int t, int w, int lane, float* sz, float* sh0, float* sh1) {
  const float tn = (float)t / 4095.f;
  const float wt = (6.283185307179586f * (float)t) / 4096.f;
  if (lane < 33) {
    float z;
    if (lane == 0) z = tn;
    else {
      int i = (lane - 1) & 15;
      float f = 1e-4f + (float)i * ((15.f - 1e-4f) / 15.f);
      float fw = f * wt;
      z = (lane <= 16) ? cosf(fw) : -sinf(fw);
    }
    sz[w * 40 + lane] = z;
  }
  __syncthreads();
  const float fr = p.f_freq[lane];
  float a = p.f_b1[lane];
#pragma unroll 1
  for (int i = 0; i < 33; ++i) a += sz[w * 40 + i] * p.f_w1[i * 64 + lane];
  sh0[w * 64 + lane] = sinf(fr * a);
  __syncthreads();
  a = p.f_b2[lane];
#pragma unroll 4
  for (int i = 0; i < 64; ++i) a += sh0[w * 64 + i] * p.f_w2[i * 64 + lane];
  sh1[w * 64 + lane] = sinf(fr * a);
  __syncthreads();
  a = p.f_b3[lane];
#pragma unroll 4
  for (int i = 0; i < 64; ++i) a += sh1[w * 64 + i] * p.f_w3[i * 64 + lane];
  __syncthreads();
  sh0[w * 64 + lane] = sinf(fr * a);
  __syncthreads();
  bf16_t* filt = (bf16_t*)(p.ws + OFF_FILT);
  const float dmin = logf(1e-2f) / 1.5f, dmax = logf(1e-2f) / 0.3f;
#pragma unroll 1
  for (int i = 0; i < 16; ++i) {
    int n = lane + 64 * i;
    float o = 0.f;
#pragma unroll 4
    for (int k = 0; k < 64; ++k) o += sh0[w * 64 + k] * p.f_w4[k * 1024 + n];
    int c = n & 511;
    float delta = dmin + (float)c * ((dmax - dmin) / 511.f);
    float win = expf(-tn * fabsf(delta));
    o *= win;
    if (n < 512) {
      if (t == 0) o += p.hy_bias[c];
      filt[(size_t)c * 8192 + 4096 + t] = f2bf(o);
    } else {
      if (t == 0) filt[(size_t)c * 8192] = 0;
      else filt[(size_t)c * 8192 + 4096 - t] = f2bf(o);
    }
  }
  __syncthreads();
}

constexpr int TR_T0 = 16 * 31, TR_T1 = 4 * 12, TR_T2 = 2 * 16, TR_T3 = 16 * 16, TR_TG = 16 * 44, TR_TD = 44 * 16, TR_TI1 = 16 * 56;
constexpr int TR_TOTAL = TR_T0 + TR_T1 + TR_T2 + TR_T3 + 4 * TR_TG + 2 * TR_TD + TR_TI1 + TR_T3;
constexpr int P0_ROPE = (4096 * 80) / 256;
constexpr int P0_FILT = 1024;
constexpr int P0_NORM = T / 4;
constexpr int P0_ITEMS = TR_TOTAL + P0_ROPE + P0_FILT + P0_NORM;

DI void phase0(const Params& p, char* smem) {
  const int tid = tidx(), lane = tid & 63, w = tid >> 6;
  for (int it = vbid(); it < P0_ITEMS; it += vgrid()) {
    if (it < TR_TOTAL) {
      int t = it;
      char* ws = p.ws;
      const float* src = p.a_w_in; size_t doff = OFF_WT_IN0; int K = 1024, N = 1952, mode = 0; const float* sc = nullptr;
      bool found = false;
      if (t < TR_T0) found = true; else t -= TR_T0;
      if (!found) { if (t < TR_T1) { found = true; src = p.a_w_q_up; doff = OFF_WT_QUP; K = 256; N = 768; sc = p.a_q_norm; } else t -= TR_T1; }
      if (!found) { if (t < TR_T2) { found = true; src = p.a_w_kv_up; doff = OFF_WT_KVUP; K = 128; N = 1024; sc = p.a_kv_norm; } else t -= TR_T2; }
      if (!found) { if (t < TR_T3) { found = true; src = p.a_w_out; doff = OFF_WT_OUT0; K = 1024; N = 1024; } else t -= TR_T3; }
      if (!found) { if (t < TR_TG) { found = true; src = p.w_gate; doff = OFF_WT_GU0; K = 1024; N = 2816; mode = 1; } else t -= TR_TG; }
      if (!found) { if (t < TR_TG) { found = true; src = p.w_gate + (size_t)1024 * 2816; doff = OFF_WT_GU1; K = 1024; N = 2816; mode = 1; } else t -= TR_TG; }
      if (!found) { if (t < TR_TG) { found = true; src = p.w_up; doff = OFF_WT_GU0; K = 1024; N = 2816; mode = 2; } else t -= TR_TG; }
      if (!found) { if (t < TR_TG) { found = true; src = p.w_up + (size_t)1024 * 2816; doff = OFF_WT_GU1; K = 1024; N = 2816; mode = 2; } else t -= TR_TG; }
      if (!found) { if (t < TR_TD) { found = true; src = p.w_down; doff = OFF_WT_DN0; K = 2816; N = 1024; } else t -= TR_TD; }
      if (!found) { if (t < TR_TD) { found = true; src = p.w_down + (size_t)1024 * 2816; doff = OFF_WT_DN1; K = 2816; N = 1024; } else t -= TR_TD; }
      if (!found) { if (t < TR_TI1) { found = true; src = p.c_w_in; doff = OFF_WT_IN1; K = 1024; N = 3584; } else t -= TR_TI1; }
      if (!found) { src = p.c_w_out; doff = OFF_WT_OUT1; K = 1024; N = 1024; }
      transpose_tile(src, (bf16_t*)(ws + doff), K, N, sc, mode, t, smem);
      continue;
    }
    int j = it - TR_TOTAL;
    if (j < P0_ROPE) {
      int idx = j * 256 + tid;
      if (idx < 4096 * 16) {
        int pos = idx >> 4, i = idx & 15;
        float inv = (float)exp2(-(double)(2 * i) / 32.0 * 13.287712379549449);
        float ang = (float)pos * inv, c, s; sincos_acc(ang, c, s);
        ((float2*)(p.ws + OFF_ROPEA))[idx] = make_float2(c, s);
      } else {
        int k = idx - 4096 * 16; int pos = k >> 6, i = k & 63;
        float inv = (float)exp2(-(double)(2 * i) / 128.0 * 13.287712379549449);
        float ang = (float)pos * inv, c, s; sincos_acc(ang, c, s);
        ((float2*)(p.ws + OFF_ROPER))[k] = make_float2(c, s);
      }
      continue;
    }
    j -= P0_ROPE;
    if (j < P0_FILT) {
      float* sf = (float*)smem;
      __syncthreads();
      hyena_filter_pos(p, j * 4 + w, w, lane, sf, sf + 160, sf + 160 + 256);
      continue;
    }
    j -= P0_FILT;
    {
      int row = j * 4 + w;
      rms_row_to_bf16(p.x + (size_t)row * 1024, p.mix_pre, (bf16_t*)(p.hbuf) + (size_t)row * 1024, lane);
    }
  }
}

template <int XIN, int XOUT>
DI void phase_resid(const void* xin_, void* xout_, const bf16_t* __restrict__ m, const float* __restrict__ gpost,
                    const float* __restrict__ gnext, bf16_t* __restrict__ hout) {
  const int lane = tidx() & 63, w = tidx() >> 6;
  for (int it = vbid(); it < T / 8; it += vgrid()) {
    const int row0 = it * 8 + w * 2;
    float mv[2][16], xv[2][16], ss[2], s2[2];
#pragma unroll
    for (int rr = 0; rr < 2; ++rr) {
      const size_t ro = (size_t)(row0 + rr) * 1024;
#pragma unroll
      for (int i = 0; i < 4; ++i) {
        u32x2 u = *(const u32x2*)(m + ro + lane * 4 + 256 * i);
        mv[rr][4 * i] = bflo(u[0]); mv[rr][4 * i + 1] = bfhi(u[0]); mv[rr][4 * i + 2] = bflo(u[1]); mv[rr][4 * i + 3] = bfhi(u[1]);
        if (XIN == 0) {
          f32x4 xo = __builtin_nontemporal_load((const f32x4*)((const float*)xin_ + ro + lane * 4 + 256 * i));
          xv[rr][4 * i] = xo[0]; xv[rr][4 * i + 1] = xo[1]; xv[rr][4 * i + 2] = xo[2]; xv[rr][4 * i + 3] = xo[3];
        } else {
          u32x2 xu = *(const u32x2*)((const bf16_t*)xin_ + ro + lane * 4 + 256 * i);
          xv[rr][4 * i] = bflo(xu[0]); xv[rr][4 * i + 1] = bfhi(xu[0]); xv[rr][4 * i + 2] = bflo(xu[1]); xv[rr][4 * i + 3] = bfhi(xu[1]);
        }
      }
    }
#pragma unroll
    for (int rr = 0; rr < 2; ++rr) {
      ss[rr] = 0.f;
#pragma unroll
      for (int q = 0; q < 16; ++q) ss[rr] += mv[rr][q] * mv[rr][q];
    }
#pragma unroll
    for (int o = 32; o >= 1; o >>= 1) { ss[0] += __shfl_xor(ss[0], o); ss[1] += __shfl_xor(ss[1], o); }
#pragma unroll
    for (int rr = 0; rr < 2; ++rr) {
      const size_t ro = (size_t)(row0 + rr) * 1024;
      const float rs = rsqrtf(ss[rr] * (1.f / 1024.f) + EPS);
      s2[rr] = 0.f;
#pragma unroll
      for (int i = 0; i < 4; ++i) {
        f32x4 gg = *(const f32x4*)(gpost + lane * 4 + 256 * i);
#pragma unroll
        for (int q = 0; q < 4; ++q) { float v = xv[rr][4 * i + q] + mv[rr][4 * i + q] * rs * gg[q]; xv[rr][4 * i + q] = v; s2[rr] += v * v; }
        if (XOUT == 0) {
          f32x4 o = {xv[rr][4 * i], xv[rr][4 * i + 1], xv[rr][4 * i + 2], xv[rr][4 * i + 3]};
          __builtin_nontemporal_store(o, (f32x4*)((float*)xout_ + ro + lane * 4 + 256 * i));
        } else {
          u32x2 o = {pack2(xv[rr][4 * i], xv[rr][4 * i + 1]), pack2(xv[rr][4 * i + 2], xv[rr][4 * i + 3])};
          *(u32x2*)((bf16_t*)xout_ + ro + lane * 4 + 256 * i) = o;
        }
      }
    }
    if (hout) {
#pragma unroll
      for (int o = 32; o >= 1; o >>= 1) { s2[0] += __shfl_xor(s2[0], o); s2[1] += __shfl_xor(s2[1], o); }
#pragma unroll
      for (int rr = 0; rr < 2; ++rr) {
        const float r2 = rsqrtf(s2[rr] * (1.f / 1024.f) + EPS);
#pragma unroll
        for (int i = 0; i < 4; ++i) {
          f32x4 gg = *(const f32x4*)(gnext + lane * 4 + 256 * i);
          u32x2 o; o[0] = pack2(xv[rr][4 * i] * r2 * gg[0], xv[rr][4 * i + 1] * r2 * gg[1]); o[1] = pack2(xv[rr][4 * i + 2] * r2 * gg[2], xv[rr][4 * i + 3] * r2 * gg[3]);
          *(u32x2*)(hout + (size_t)(row0 + rr) * 1024 + lane * 4 + 256 * i) = o;
        }
      }
    }
  }
}

DI void phase_gemm_plain(const bf16_t* A, int lda, const bf16_t* Wt, int K, int N, bf16_t* C, int ldc, char* smem) {
  const int NT = (N + 127) >> 7, MT = T / 128;
  for (int t = vbid(); t < MT * NT; t += vgrid()) {
    const int mt = t / NT, nt = t - mt * NT;
    LoadRows al{A, lda, mt * 128, T};
    LoadRows bl{Wt, K, nt * 128, N};
    EpStore ep{C, ldc, mt * 128, nt * 128, N};
    gemm_tile(al, bl, ep, K, smem);
  }
}

struct EpStore256 {
  static constexpr bool kBf16 = true;
  bf16_t* dst; int ld; int m0; int n0; int N;
  DI void operator()(const bf16_t* sCb) const {
    for (int id = tid512(); id < 8192; id += 512) {
      int row = id >> 5, c8 = (id & 31) * 8, n = n0 + c8;
      if (n < N) *(u32x4*)(dst + (size_t)(m0 + row) * ld + n) = *(const u32x4*)(sCb + row * BLD + c8);
    }
  }
};
DI void phase_gemm_plain256(const Sched& sc, const bf16_t* A, int lda, const bf16_t* Wt, int K, int N, bf16_t* C, int ldc, char* smem) {
  const int NT = (N + 255) >> 8, MT = T / 256;
  for (int round = 0;; ++round) {
    int mt = 0, nt = 0;
    const int st = sched_tile(sc, round, MT, NT, mt, nt);
    if (st == 2) break;
    if (st == 1) continue;
    LoadRows al{A, lda, mt * 256, T};
    LoadRows bl{Wt, K, nt * 256, N};
    EpStore256 ep{C, ldc, mt * 256, nt * 256, N};
    gemm_tile256(al, bl, ep, K, smem);
  }
}

DI void row_rs(const bf16_t* base, int ld, int m0, int ncols, float* srs) {
  const int tid = tidx(), row = tid >> 1, half = tid & 1;
  const bf16_t* pr = base + (size_t)(m0 + row) * ld + half * (ncols >> 1);
  float ss = 0.f;
  for (int c = 0; c < (ncols >> 1); c += 8) {
    u32x4 u = ldg16(pr + c);
#pragma unroll
    for (int q = 0; q < 4; ++q) { float a = bflo(u[q]), b = bfhi(u[q]); ss += a * a + b * b; }
  }
  ss += __shfl_xor(ss, 1);
  if (half == 0) srs[row] = rsqrtf(ss / (float)ncols + EPS);
}

struct EpQup {
  const Params* p; int m0; int n0;
  DI void operator()(float* sC) const {
    float* srs = sC + 128 * CLD;
    const bf16_t* P = (const bf16_t*)(p->ws + OFF_P);
    row_rs(P, 1952, m0, 256, srs);
    __syncthreads();
    const float2* rope = (const float2*)(p->ws + OFF_ROPEA);
    bf16_t* Qm = (bf16_t*)(p->ws + OFF_QM);
    const float qs = 0.10206207261596575f * LOG2E;
    for (int id = tidx(); id < 2048; id += 256) {
      int row = id >> 4, c8 = (id & 15) * 8, n = n0 + c8;
      float v[8]; ld8f(sC + row * CLD + c8, v);
      int d = n % 96;
      if (d >= 64) {
        int pos = (m0 + row) & 4095;
        bool first = (d - 64) < 16;
        int i0 = (d - 64) & 15;
        float pv[8]; ld8f(sC + row * CLD + c8 + (first ? 16 : -16), pv);
#pragma unroll
        for (int j = 0; j < 8; ++j) {
          float2 cs = rope[pos * 16 + i0 + j];
          v[j] = first ? (v[j] * cs.x - pv[j] * cs.y) : (v[j] * cs.x + pv[j] * cs.y);
        }
      }
      float sc = srs[row] * qs;
#pragma unroll
      for (int j = 0; j < 8; ++j) v[j] *= sc;
      store8(Qm + (size_t)(m0 + row) * 768 + n, v);
    }
  }
};

struct EpKVup {
  const Params* p; int m0; int nt;
  DI void operator()(float* sC) const {
    float* srs = sC + 128 * CLD;
    const bf16_t* P = (const bf16_t*)(p->ws + OFF_P);
    row_rs(P + 256, 1952, m0, 128, srs);
    __syncthreads();
    bf16_t* Kf = (bf16_t*)(p->ws + OFF_KF);
    bf16_t* Vt = (bf16_t*)(p->ws + OFF_VTM);
    const int hh = nt;
    for (int id = tidx(); id < 1024; id += 256) {
      int row = id >> 3, c8 = (id & 7) * 8;
      float v[8]; ld8f(sC + row * CLD + c8, v);
      float sc = srs[row];
#pragma unroll
      for (int j = 0; j < 8; ++j) v[j] *= sc;
      store8(Kf + (size_t)(m0 + row) * 768 + hh * 96 + c8, v);
    }
    const int b = m0 >> 12, s0 = m0 & 4095;
    for (int id = tidx(); id < 1024; id += 256) {
      int col = id & 63, rch = id >> 6;
      float v[8];
#pragma unroll
      for (int j = 0; j < 8; ++j) v[j] = sC[(rch * 8 + j) * CLD + 64 + col] * srs[rch * 8 + j];
      store8(Vt + ((size_t)(b * 8 + hh) * 64 + col) * 4096 + s0 + rch * 8, v);
    }
    if (nt == 0) {
      const float2* rope = (const float2*)(p->ws + OFF_ROPEA);
      for (int id = tidx(); id < 512; id += 256) {
        int row = id >> 2, c4 = id & 3;
        int pos = (m0 + row) & 4095;
        u32x4 u = ldg16(P + (size_t)(m0 + row) * 1952 + 384 + c4 * 8);
        u32x4 q = ldg16(P + (size_t)(m0 + row) * 1952 + 384 + (c4 ^ 2) * 8);
        bool first = c4 < 2;
        int i0 = (c4 & 1) * 8;
        float v[8];
#pragma unroll
        for (int j = 0; j < 8; ++j) {
          float a = (j & 1) ? bfhi(u[j >> 1]) : bflo(u[j >> 1]);
          float o = (j & 1) ? bfhi(q[j >> 1]) : bflo(q[j >> 1]);
          float2 cs = rope[pos * 16 + i0 + j];
          v[j] = first ? (a * cs.x - o * cs.y) : (a * cs.x + o * cs.y);
        }
#pragma unroll
        for (int h8 = 0; h8 < 8; ++h8) store8(Kf + (size_t)(m0 + row) * 768 + h8 * 96 + 64 + c4 * 8, v);
      }
    }
  }
};

DI void transpose_bf16_64(const bf16_t* __restrict__ src, int lds_, bf16_t* __restrict__ dst, int ldd, char* smem) {
  bf16_t* sT = (bf16_t*)smem;
  const int tid = tidx();
  __syncthreads();
#pragma unroll
  for (int i = 0; i < 2; ++i) {
    int row = (tid >> 3) + 32 * i, ck = tid & 7;
    u32x4 u = ldg16(src + (size_t)row * lds_ + ck * 8);
#pragma unroll
    for (int j = 0; j < 8; ++j) { unsigned wv = u[j >> 1]; sT[(ck * 8 + j) * 72 + row] = (bf16_t)((j & 1) ? (wv >> 16) : (wv & 0xffffu)); }
  }
  __syncthreads();
#pragma unroll
  for (int i = 0; i < 2; ++i) {
    int row = (tid >> 3) + 32 * i, ck = tid & 7;
    *(u32x4*)(dst + (size_t)row * ldd + ck * 8) = *(const u32x4*)(sT + row * 72 + ck * 8);
  }
}

constexpr int P2_QUP = 256 * 6, P2_KVUP = 256 * 8, P2_VT = 512 * 8;
DI void phase2(const Params& p, char* smem) {
  const bf16_t* P = (const bf16_t*)(p.ws + OFF_P);
  for (int it = vbid(); it < P2_QUP + P2_KVUP + P2_VT; it += vgrid()) {
    if (it < P2_QUP) {
      int mt = it / 6, nt = it - mt * 6;
      LoadRows al{P, 1952, mt * 128, T};
      LoadRows bl{(const bf16_t*)(p.ws + OFF_WT_QUP), 256, nt * 128, 768};
      EpQup ep{&p, mt * 128, nt * 128};
      gemm_tile(al, bl, ep, 256, smem);
    } else if (it < P2_QUP + P2_KVUP) {
      int j = it - P2_QUP; int mt = j >> 3, nt = j & 7;
      LoadRows al{P + 256, 1952, mt * 128, T};
      LoadRows bl{(const bf16_t*)(p.ws + OFF_WT_KVUP), 128, nt * 128, 1024};
      EpKVup ep{&p, mt * 128, nt};
      gemm_tile(al, bl, ep, 128, smem);
    } else {
      int j = it - P2_QUP - P2_KVUP; int tt = j >> 3, hh = j & 7;
      int b = tt >> 6, s0 = (tt & 63) * 64;
      transpose_bf16_64(P + (size_t)(tt * 64) * 1952 + 1440 + hh * 64, 1952,
                        (bf16_t*)(p.ws + OFF_VTN) + ((size_t)(b * 8 + hh) * 64) * 4096 + s0, 4096, smem);
    }
  }
}

template <int DQK, bool NA>
DI void attn_unit(const bf16_t* __restrict__ Qb, int ldq, const bf16_t* __restrict__ Kb, int ldk, const bf16_t* __restrict__ Vt,
                  bf16_t* __restrict__ Ob, int ldo, int u, float sc, const float* __restrict__ rpb_h, char* smem) {
  constexpr int KS = DQK + 8;
  constexpr int NKC = DQK / 8;
  constexpr int KCH = 64 * NKC;
  constexpr int NDS = DQK / 16;
  bf16_t* sK = (bf16_t*)smem;
  bf16_t* sV = sK + 2 * 64 * KS;
  float* sBias = (float*)(sV + 2 * 64 * 72);
  const int tid = tid512(), lane = tid & 63, w = tid >> 6, r = lane & 31, h = lane >> 5;
  int t_lo = 0, t_hi = 63;
  int rq = 0, rs = 0, cq = 0, cs = 0;
  if (NA) {
    int r0 = 4 * u;
    t_lo = clampi(r0 - 4, 0, 56);
    t_hi = clampi(r0 + 3 - 4, 0, 56) + 7;
    rq = r0 + (w >> 1); rs = clampi(rq - 4, 0, 56);
    cq = 32 * (w & 1) + r; cs = clampi(cq - 8, 0, 48);
  }
  __syncthreads();
  if (NA) { for (int i = tid; i < 15 * 31; i += 512) sBias[i] = rpb_h[i] * LOG2E; }
  u32x4 qf[NDS];
  {
    const bf16_t* qp = Qb + (size_t)(256 * u + 32 * w + r) * ldq + 8 * h;
#pragma unroll
    for (int ds = 0; ds < NDS; ++ds) qf[ds] = ldg16(qp + 16 * ds);
  }
  u32x4 kreg[2], vreg;
  const bool k2 = (tid + 512) < KCH;
  const int krow0 = tid / NKC, kck0 = tid - krow0 * NKC;
  const int krow1 = (tid + 512) / NKC, kck1 = (tid + 512) - krow1 * NKC;
  const int vrow = tid >> 3, vck = tid & 7;
  auto load_tile = [&](int kt) {
    kreg[0] = ldg16(Kb + (size_t)(64 * kt + krow0) * ldk + kck0 * 8);
    if (k2) kreg[1] = ldg16(Kb + (size_t)(64 * kt + krow1) * ldk + kck1 * 8);
    vreg = ldg16(Vt + (size_t)vrow * 4096 + 64 * kt + vck * 8);
  };
  auto store_tile = [&](int buf) {
    bf16_t* dK = sK + buf * 64 * KS; bf16_t* dV = sV + buf * 64 * 72;
    *(u32x4*)(dK + krow0 * KS + kck0 * 8) = kreg[0];
    if (k2) *(u32x4*)(dK + krow1 * KS + kck1 * 8) = kreg[1];
    const int g = vck >> 1, odd = vck & 1;
    u32x2 lo = {vreg[0], vreg[1]}, hi = {vreg[2], vreg[3]};
    *(u32x2*)(dV + vrow * 72 + g * 16 + (odd ? 4 : 0)) = lo;
    *(u32x2*)(dV + vrow * 72 + g * 16 + (odd ? 12 : 8)) = hi;
  };
  load_tile(t_lo);
  store_tile(0);
  __syncthreads();
  f32x16 o0, o1;
#pragma unroll
  for (int q = 0; q < 16; ++q) { o0[q] = 0.f; o1[q] = 0.f; }
  float m_run = -INFINITY, l_run = 0.f;
  for (int kt = t_lo; kt <= t_hi; ++kt) {
    const int cur = (kt - t_lo) & 1;
    const bool more = kt < t_hi;
    if (more) load_tile(kt + 1);
    bool active = true;
    if (NA) active = (kt >= rs) && (kt < rs + 8);
    if (active) {
      const bf16_t* cK = sK + cur * 64 * KS + r * KS + 8 * h;
      const bf16_t* cV = sV + cur * 64 * 72 + r * 72 + 8 * h;
      f32x16 s0, s1;
      {
        const f32x16 zero16 = {0.f, 0.f, 0.f, 0.f, 0.f, 0.f, 0.f, 0.f, 0.f, 0.f, 0.f, 0.f, 0.f, 0.f, 0.f, 0.f};
        u32x4 k0 = *(const u32x4*)(cK);
        u32x4 k1 = *(const u32x4*)(cK + 32 * KS);
        s0 = MFMA32(k0, qf[0], zero16);
        s1 = MFMA32(k1, qf[0], zero16);
      }
#pragma unroll
      for (int ds = 1; ds < NDS; ++ds) {
        u32x4 k0 = *(const u32x4*)(cK + ds * 16);
        u32x4 k1 = *(const u32x4*)(cK + 32 * KS + ds * 16);
        s0 = MFMA32(k0, qf[ds], s0);
        s1 = MFMA32(k1, qf[ds], s1);
      }
      if (NA) {
        const int brow = (kt - rq + 7) * 31;
#pragma unroll
        for (int q = 0; q < 16; ++q) {
          int kc0 = crow(q, h), kc1 = 32 + kc0;
          bool v0 = (kc0 >= cs) && (kc0 < cs + 16), v1 = (kc1 >= cs) && (kc1 < cs + 16);
          float b0 = v0 ? sBias[brow + kc0 - cq + 15] : 0.f;
          float b1 = v1 ? sBias[brow + kc1 - cq + 15] : 0.f;
          s0[q] = v0 ? (s0[q] * sc + b0) : -INFINITY;
          s1[q] = v1 ? (s1[q] * sc + b1) : -INFINITY;
        }
      }
      float mx = s0[0];
#pragma unroll
      for (int q = 1; q < 16; ++q) mx = fmaxf(mx, s0[q]);
#pragma unroll
      for (int q = 0; q < 16; ++q) mx = fmaxf(mx, s1[q]);
      mx = fmaxf(mx, __shfl_xor(mx, 32));
      if (__builtin_amdgcn_ballot_w64((mx - m_run) > 8.f) != 0ull) {
        const float m_new = fmaxf(m_run, mx);
        const float alpha = ex2(m_run - m_new);
        m_run = m_new;
        l_run *= alpha;
#pragma unroll
        for (int q = 0; q < 16; ++q) { o0[q] *= alpha; o1[q] *= alpha; }
      }
      const f2_t nm = {-m_run, -m_run};
      f2_t ls2 = {0.f, 0.f};
#pragma unroll
      for (int q = 0; q < 16; q += 2) {
        f2_t a = {s0[q], s0[q + 1]}, b = {s1[q], s1[q + 1]};
        a = a + nm; b = b + nm;
        a[0] = ex2(a[0]); a[1] = ex2(a[1]); b[0] = ex2(b[0]); b[1] = ex2(b[1]);
        s0[q] = a[0]; s0[q + 1] = a[1]; s1[q] = b[0]; s1[q + 1] = b[1];
        ls2 = ls2 + a; ls2 = ls2 + b;
      }
      l_run += ls2[0] + ls2[1];
      u32x4 pf[4];
#pragma unroll
      for (int s = 0; s < 2; ++s) {
        pf[s][0] = pack2(s0[8 * s], s0[8 * s + 1]); pf[s][1] = pack2(s0[8 * s + 2], s0[8 * s + 3]);
        pf[s][2] = pack2(s0[8 * s + 4], s0[8 * s + 5]); pf[s][3] = pack2(s0[8 * s + 6], s0[8 * s + 7]);
        pf[2 + s][0] = pack2(s1[8 * s], s1[8 * s + 1]); pf[2 + s][1] = pack2(s1[8 * s + 2], s1[8 * s + 3]);
        pf[2 + s][2] = pack2(s1[8 * s + 4], s1[8 * s + 5]); pf[2 + s][3] = pack2(s1[8 * s + 6], s1[8 * s + 7]);
      }
#pragma unroll
      for (int ks = 0; ks < 4; ++ks) {
        u32x4 v0 = *(const u32x4*)(cV + ks * 16);
        u32x4 v1 = *(const u32x4*)(cV + 32 * 72 + ks * 16);
        o0 = MFMA32(v0, pf[ks], o0);
        o1 = MFMA32(v1, pf[ks], o1);
      }
    }
    if (more) store_tile(cur ^ 1);
    __syncthreads();
  }
  l_run += __shfl_xor(l_run, 32);
  const float inv = 1.f / l_run;
  bf16_t* op = Ob + (size_t)(256 * u + 32 * w + r) * ldo;
#pragma unroll
  for (int g = 0; g < 4; ++g) {
    u32x2 a = {pack2(o0[4 * g] * inv, o0[4 * g + 1] * inv), pack2(o0[4 * g + 2] * inv, o0[4 * g + 3] * inv)};
    u32x2 b = {pack2(o1[4 * g] * inv, o1[4 * g + 1] * inv), pack2(o1[4 * g + 2] * inv, o1[4 * g + 3] * inv)};
    *(u32x2*)(op + 8 * g + 4 * h) = a;
    *(u32x2*)(op + 32 + 8 * g + 4 * h) = b;
  }
}

DI void phase3(const Sched& sc, const Params& p, char* smem) {
  bf16_t* AB = (bf16_t*)(p.ws + OFF_AB);
  int P = sc.minloc / 16; P = P < 1 ? 1 : P;
  const bool act = sc.rank < P * 16;
  const int u = sc.rank & 15;
  for (int kind = 0; kind < 2; ++kind) {
    for (int round = 0;; ++round) {
      const int pair0 = (round * sc.nx + sc.xs) * P;
      if (pair0 >= 64) break;
      const int pair = pair0 + (sc.rank >> 4);
      if (!act || pair >= 64) continue;
      const int hh = pair & 7, b = pair >> 3;
      if (kind == 0) {
        attn_unit<96, false>((const bf16_t*)(p.ws + OFF_QM) + (size_t)b * 4096 * 768 + hh * 96, 768,
                             (const bf16_t*)(p.ws + OFF_KF) + (size_t)b * 4096 * 768 + hh * 96, 768,
                             (const bf16_t*)(p.ws + OFF_VTM) + (size_t)(b * 8 + hh) * 64 * 4096,
                             AB + (size_t)b * 4096 * 1024 + hh * 64, 1024, u, 1.f, nullptr, smem);
      } else {
        const bf16_t* Pm = (const bf16_t*)(p.ws + OFF_P) + (size_t)b * 4096 * 1952;
        attn_unit<64, true>(Pm + 416 + hh * 64, 1952, Pm + 928 + hh * 64, 1952,
                            (const bf16_t*)(p.ws + OFF_VTN) + (size_t)(b * 8 + hh) * 64 * 4096,
                            AB + (size_t)b * 4096 * 1024 + 512 + hh * 64, 1024, u, 0.125f * LOG2E, p.a_rpb + hh * 15 * 31, smem);
      }
    }
  }
}

struct LoadFfnA {
  const bf16_t* H; int b; int p0;
  DI u32x4 operator()(int r, int k) const {
    int pos = clampi(p0 + r, 0, 4095);
    return ldg16(H + ((size_t)b * 4096 + pos) * 1024 + k);
  }
};
struct EpFfnUp {
  const float* conv; bf16_t* hid; int b; int p0; int c0;
  DI void operator()(const float* sC) const {
    for (int id = tidx(); id < 126 * 8; id += 256) {
      int rr = id >> 3, c8 = (id & 7) * 8, row = rr + 1, pos = p0 + row;
      if (pos < 4096) {
        float gm[8], g0[8], gp[8], uu[8], w0[8], w1[8], w2[8], v[8];
        ld8f(sC + (row - 1) * CLD + c8, gm); ld8f(sC + row * CLD + c8, g0); ld8f(sC + (row + 1) * CLD + c8, gp); ld8f(sC + row * CLD + 64 + c8, uu);
        if (pos == 0) { _Pragma("unroll") for (int j = 0; j < 8; ++j) gm[j] = 0.f; }
        if (pos == 4095) { _Pragma("unroll") for (int j = 0; j < 8; ++j) gp[j] = 0.f; }
        ld8f(conv + c0 + c8, w0); ld8f(conv + DFF + c0 + c8, w1); ld8f(conv + 2 * DFF + c0 + c8, w2);
#pragma unroll
        for (int j = 0; j < 8; ++j) {
          float g = w0[j] * gm[j] + w1[j] * g0[j] + w2[j] * gp[j];
          float y = 0.7978845608028654f * (g + 0.044715f * g * g * g);
          float e = __expf(-2.f * y);
          v[j] = g * __builtin_amdgcn_rcpf(1.f + e) * uu[j];
        }
        store8(hid + ((size_t)b * 4096 + pos) * DFF + c0 + c8, v);
      }
    }
  }
};
DI void phase_ffn_up(const Params& p, int layer, char* smem) {
  const bf16_t* H = (const bf16_t*)(p.hbuf);
  const bf16_t* Wt = (const bf16_t*)(p.ws + (layer ? OFF_WT_GU1 : OFF_WT_GU0));
  for (int t = vbid(); t < 264 * 44; t += vgrid()) {
    int mt = t / 44, nt = t - mt * 44, b = mt / 33, j = mt - b * 33;
    LoadFfnA al{H, b, 126 * j - 1};
    LoadRows bl{Wt, 1024, nt * 128, 5632};
    EpFfnUp ep{p.ffn_conv + (size_t)layer * 3 * DFF, (bf16_t*)(p.ws + OFF_HID), b, 126 * j - 1, nt * 64};
    gemm_tile(al, bl, ep, 1024, smem);
  }
}

constexpr size_t OFF_HG = OFF_M;
constexpr size_t OFF_HU = OFF_M + (size_t)128 * 4 * DFF * 2;
DI float gelu_gate(float g, float u) {
  float y = g * (-2.3022081985f - 0.1029432396f * g * g);
  return g * __builtin_amdgcn_rcpf(1.f + ex2(y)) * u;
}
struct EpFfnUp256 {
  static constexpr bool kBf16 = true;
  const float* conv; bf16_t* hid; bf16_t* hg; bf16_t* hu; int mt; int c0;
  DI void operator()(const bf16_t* sCb) const {
    const int t = tid512(), hf = (t >> 3) & 1, c8 = (t & 7) * 8;
    const int cb = c0 + 64 * hf;
    const bf16_t* base = sCb + 128 * hf;
    float w0[8], w1[8], w2[8];
    ld8f(conv + cb + c8, w0); ld8f(conv + DFF + cb + c8, w1); ld8f(conv + 2 * DFF + cb + c8, w2);
    for (int rr = t >> 4; rr < 254; rr += 32) {
      const int row = rr + 1;
      float gm[8], g0[8], gp[8], uu[8], v[8];
      ld8b(base + (row - 1) * BLD + c8, gm); ld8b(base + row * BLD + c8, g0); ld8b(base + (row + 1) * BLD + c8, gp); ld8b(base + row * BLD + 64 + c8, uu);
#pragma unroll
      for (int j = 0; j < 8; ++j) v[j] = gelu_gate(w0[j] * gm[j] + w1[j] * g0[j] + w2[j] * gp[j], uu[j]);
      store8(hid + ((size_t)mt * 256 + row) * DFF + cb + c8, v);
    }
    if (t < 16 * 6) {
      const int which = t >> 4;
      const int row = which < 4 ? ((which & 1) + 254 * (which >> 1)) : (which == 4 ? 0 : 255);
      const u32x4 val = *(const u32x4*)(base + row * BLD + (which < 4 ? 0 : 64) + c8);
      bf16_t* dst = which < 4 ? hg + ((size_t)mt * 4 + which) * DFF : hu + ((size_t)mt * 2 + (which - 4)) * DFF;
      *(u32x4*)(dst + cb + c8) = val;
    }
  }
};
DI void ffn_fixup(const Params& p, int layer) {
  const float* conv = p.ffn_conv + (size_t)layer * 3 * DFF;
  const bf16_t* hg = (const bf16_t*)(p.ws + OFF_HG);
  const bf16_t* hu = (const bf16_t*)(p.ws + OFF_HU);
  bf16_t* hid = (bf16_t*)(p.ws + OFF_HID);
  for (int id = (int)blockIdx.x * 512 + tid512(); id < 128 * 2 * 352; id += (int)gridDim.x * 512) {
    const int c = (id % 352) * 8, e = (id / 352) & 1, mt = id / 704;
    float gm[8], g0[8], gp[8], uu[8], w0[8], w1[8], w2[8], v[8];
    ld8f(conv + c, w0); ld8f(conv + DFF + c, w1); ld8f(conv + 2 * DFF + c, w2);
    int row;
    if (e == 0) {
      row = 0;
      if ((mt & 15) != 0) ld8b(hg + ((size_t)(mt - 1) * 4 + 3) * DFF + c, gm); else { _Pragma("unroll") for (int j = 0; j < 8; ++j) gm[j] = 0.f; }
      ld8b(hg + ((size_t)mt * 4 + 0) * DFF + c, g0); ld8b(hg + ((size_t)mt * 4 + 1) * DFF + c, gp); ld8b(hu + ((size_t)mt * 2 + 0) * DFF + c, uu);
    } else {
      row = 255;
      ld8b(hg + ((size_t)mt * 4 + 2) * DFF + c, gm); ld8b(hg + ((size_t)mt * 4 + 3) * DFF + c, g0); ld8b(hu + ((size_t)mt * 2 + 1) * DFF + c, uu);
      if ((mt & 15) != 15) ld8b(hg + ((size_t)(mt + 1) * 4 + 0) * DFF + c, gp); else { _Pragma("unroll") for (int j = 0; j < 8; ++j) gp[j] = 0.f; }
    }
#pragma unroll
    for (int j = 0; j < 8; ++j) v[j] = gelu_gate(w0[j] * gm[j] + w1[j] * g0[j] + w2[j] * gp[j], uu[j]);
    store8(hid + ((size_t)mt * 256 + row) * DFF + c, v);
  }
}
DI void phase_ffn_up256(const Sched& sc, const Params& p, int layer, char* smem) {
  const bf16_t* H = (const bf16_t*)(p.hbuf);
  const bf16_t* Wt = (const bf16_t*)(p.ws + (layer ? OFF_WT_GU1 : OFF_WT_GU0));
  for (int round = 0;; ++round) {
    int mt = 0, nt = 0;
    const int st = sched_tile(sc, round, 128, 22, mt, nt);
    if (st == 2) break;
    if (st == 1) continue;
    LoadRows al{H, 1024, mt * 256, T};
    LoadRows bl{Wt, 1024, nt * 256, 5632};
    EpFfnUp256 ep{p.ffn_conv + (size_t)layer * 3 * DFF, (bf16_t*)(p.ws + OFF_HID), (bf16_t*)(p.ws + OFF_HG), (bf16_t*)(p.ws + OFF_HU), mt, nt * 128};
    gemm_tile256(al, bl, ep, 1024, smem);
  }
}

struct EpIn1 {
  const Params* p; int m0; int nt; float rscale;
  DI void operator()(float* sC) const {
    const int b = m0 >> 12, s0 = m0 & 4095;
    char* ws = p->ws;
    if (nt < 8) {
      const float2* rope = (const float2*)(ws + OFF_ROPER);
      const float sc = (nt >= 4) ? 0.08838834764831845f : 1.f;
      for (int id = tidx(); id < 128 * 64; id += 256) {
        int row = id >> 6, i = id & 63;
        float2 cs = rope[(size_t)(s0 + row) * 64 + i];
        float x1 = sC[row * CLD + i], x2 = sC[row * CLD + i + 64];
        sC[row * CLD + i] = (x1 * cs.x - x2 * cs.y) * sc;
        sC[row * CLD + i + 64] = (x1 * cs.y + x2 * cs.x) * sc;
      }
      __syncthreads();
    }
    bf16_t* nat = nullptr; int ldn = 512, coff = 0;
    if (nt < 4) { nat = (bf16_t*)(ws + OFF_RQ); coff = nt * 128; }
    else if (nt < 8) { nat = (bf16_t*)(ws + OFF_RK); coff = (nt - 4) * 128; }
    else if (nt < 12) { nat = nullptr; }
    else if (nt < 16) { nat = (bf16_t*)(ws + OFF_RG); coff = (nt - 12) * 128; }
    else { nat = (bf16_t*)(ws + OFF_HY); ldn = 1536; coff = (nt - 16) * 128; }
    if (nat) {
      for (int id = tidx(); id < 2048; id += 256) {
        int row = id >> 4, c8 = (id & 15) * 8;
        float v[8]; ld8f(sC + row * CLD + c8, v);
        store8(nat + (size_t)(m0 + row) * ldn + coff + c8, v);
      }
    }
    if (nt >= 4 && nt < 12) {
      bf16_t* tp = (bf16_t*)(ws + (nt < 8 ? OFF_RKT : OFF_RVT));
      int hh = (nt - 4) & 3;
      for (int id = tidx(); id < 128 * 16; id += 256) {
        int col = id & 127, rch = id >> 7;
        float v[8];
#pragma unroll
        for (int j = 0; j < 8; ++j) v[j] = sC[(rch * 8 + j) * CLD + col];
        store8(tp + ((size_t)(b * 4 + hh) * 128 + col) * 4096 + s0 + rch * 8, v);
      }
    }
  }
};
DI void phase_in1(const Params& p, char* smem) {
  const bf16_t* H = (const bf16_t*)(p.hbuf);
  const bf16_t* Wt = (const bf16_t*)(p.ws + OFF_WT_IN1);
  for (int t = vbid(); t < 256 * 28; t += vgrid()) {
    int mt = t / 28, nt = t - mt * 28;
    LoadRows al{H, 1024, mt * 128, T};
    LoadRows bl{Wt, 1024, nt * 128, 3584};
    EpIn1 ep{&p, mt * 128, nt, 1.f};
    gemm_tile(al, bl, ep, 1024, smem);
  }
}

struct EpIn1_256 {
  static constexpr bool kBf16 = true;
  const Params* p; int m0; int nt2;
  DI void operator()(bf16_t* sCb) const {
    const int b = m0 >> 12, s0 = m0 & 4095;
    char* ws = p->ws;
    if (nt2 < 4) {
      const float2* rope = (const float2*)(ws + OFF_ROPER);
      const float sc = (nt2 >= 2) ? 0.08838834764831845f : 1.f;
      for (int id = tid512(); id < 256 * 128; id += 512) {
        int row = id >> 7, hf = (id >> 6) & 1, i = id & 63;
        float2 cs = rope[(size_t)(s0 + row) * 64 + i];
        bf16_t* q1 = sCb + row * BLD + 128 * hf + i;
        float x1 = bf2f(q1[0]), x2 = bf2f(q1[64]);
        q1[0] = f2bf((x1 * cs.x - x2 * cs.y) * sc);
        q1[64] = f2bf((x1 * cs.y + x2 * cs.x) * sc);
      }
      __syncthreads();
    }
#pragma unroll 1
    for (int hf = 0; hf < 2; ++hf) {
      const int nt = 2 * nt2 + hf;
      const bf16_t* base = sCb + 128 * hf;
      bf16_t* nat = nullptr; int ldn = 512, coff = 0;
      if (nt < 4) { nat = (bf16_t*)(ws + OFF_RQ); coff = nt * 128; }
      else if (nt < 8) { nat = (bf16_t*)(ws + OFF_RK); coff = (nt - 4) * 128; }
      else if (nt < 12) { nat = nullptr; }
      else if (nt < 16) { nat = (bf16_t*)(ws + OFF_RG); coff = (nt - 12) * 128; }
      else { nat = (bf16_t*)(ws + OFF_HY); ldn = 1536; coff = (nt - 16) * 128; }
      if (nat) {
        for (int id = tid512(); id < 4096; id += 512) {
          int row = id >> 4, c8 = (id & 15) * 8;
          *(u32x4*)(nat + (size_t)(m0 + row) * ldn + coff + c8) = *(const u32x4*)(base + row * BLD + c8);
        }
      }
      if (nt >= 4 && nt < 12) {
        bf16_t* tp = (bf16_t*)(ws + (nt < 8 ? OFF_RKT : OFF_RVT));
        int hh = (nt - 4) & 3;
        for (int id = tid512(); id < 128 * 32; id += 512) {
          int col = id & 127, rch = id >> 7;
          unsigned short e[8];
#pragma unroll
          for (int j = 0; j < 8; ++j) e[j] = base[(rch * 8 + j) * BLD + col];
          u32x4 o = {(unsigned)e[0] | ((unsigned)e[1] << 16), (unsigned)e[2] | ((unsigned)e[3] << 16), (unsigned)e[4] | ((unsigned)e[5] << 16), (unsigned)e[6] | ((unsigned)e[7] << 16)};
          *(u32x4*)(tp + ((size_t)(b * 4 + hh) * 128 + col) * 4096 + s0 + rch * 8) = o;
        }
      }
    }
  }
};
DI void phase_in1_256(const Sched& sc, const Params& p, char* smem) {
  const bf16_t* H = (const bf16_t*)(p.hbuf);
  const bf16_t* Wt = (const bf16_t*)(p.ws + OFF_WT_IN1);
  for (int round = 0;; ++round) {
    int mt = 0, nt = 0;
    const int st = sched_tile(sc, round, 128, 14, mt, nt);
    if (st == 2) break;
    if (st == 1) continue;
    LoadRows al{H, 1024, mt * 256, T};
    LoadRows bl{Wt, 1024, nt * 256, 3584};
    EpIn1_256 ep{&p, mt * 256, nt};
    gemm_tile256(al, bl, ep, 1024, smem);
  }
}

DI float log_sigmoid(float x) { return fminf(x, 0.f) - log1pf(expf(-fabsf(x))); }

struct LoadKtScaled {
  const bf16_t* base; float l2g; int mode;
  DI u32x4 operator()(int r, int k) const {
    u32x4 u = ldg16(base + (size_t)r * 4096 + k);
    u32x4 o;
#pragma unroll
    for (int q = 0; q < 4; ++q) {
      int c = k + 2 * q;
      float e0 = mode ? (float)c : (float)(127 - c), e1 = mode ? (float)(c + 1) : (float)(126 - c);
      o[q] = pack2(bflo(u[q]) * ex2(e0 * l2g), bfhi(u[q]) * ex2(e1 * l2g));
    }
    return o;
  }
};
struct LoadStrided { const bf16_t* base; DI u32x4 operator()(int r, int k) const { return ldg16(base + (size_t)r * 4096 + k); } };

DI void hyena_pre_tile(const Params& p, int item, char* smem) {
  const int tid = tidx();
  const int ct = item & 7, st = (item >> 3) & 63, b = item >> 9;
  const bf16_t* HY = (const bf16_t*)(p.ws + OFF_HY) + (size_t)b * 4096 * 1536;
  bf16_t* sT = (bf16_t*)smem;
  __syncthreads();
#pragma unroll
  for (int i = 0; i < 2; ++i) {
    int row = (tid >> 3) + 32 * i, ck = tid & 7, s = st * 64 + row, c = ct * 64 + ck * 8;
    float x1[8], vv[8];
#pragma unroll
    for (int j = 0; j < 8; ++j) { x1[j] = 0.f; vv[j] = 0.f; }
#pragma unroll
    for (int d = -1; d <= 1; ++d) {
      int ss = s + d;
      if (ss >= 0 && ss < 4096) {
        u32x4 a = ldg16(HY + (size_t)ss * 1536 + 512 + c), bb = ldg16(HY + (size_t)ss * 1536 + 1024 + c);
        float wa[8], wb[8]; ld8f(p.c_short + (d + 1) * 1536 + 512 + c, wa); ld8f(p.c_short + (d + 1) * 1536 + 1024 + c, wb);
#pragma unroll
        for (int q = 0; q < 4; ++q) {
          x1[2 * q] += wa[2 * q] * bflo(a[q]); x1[2 * q + 1] += wa[2 * q + 1] * bfhi(a[q]);
          vv[2 * q] += wb[2 * q] * bflo(bb[q]); vv[2 * q + 1] += wb[2 * q + 1] * bfhi(bb[q]);
        }
      }
    }
#pragma unroll
    for (int j = 0; j < 8; ++j) sT[(ck * 8 + j) * 72 + row] = f2bf(x1[j] * vv[j]);
  }
  __syncthreads();
  bf16_t* uT = (bf16_t*)(p.hbuf + HB_UT);
#pragma unroll
  for (int i = 0; i < 2; ++i) {
    int row = (tid >> 3) + 32 * i, ck = tid & 7;
    *(u32x4*)(uT + ((size_t)(ct * 64 + row) * 8 + b) * 4096 + st * 64 + ck * 8) = *(const u32x4*)(sT + row * 72 + ck * 8);
  }
}

struct EpKV {
  bf16_t* dst;
  DI void operator()(const float* sC) const {
    for (int id = tidx(); id < 2048; id += 256) {
      int row = id >> 4, c8 = (id & 15) * 8;
      float v[8]; ld8f(sC + row * CLD + c8, v); store8(dst + row * 128 + c8, v);
    }
  }
};

constexpr int P10_KV = 2048, P10_HY = 4096;
DI void phase10(const Params& p, char* smem) {
  for (int it = vbid(); it < P10_KV + P10_HY; it += vgrid()) {
    if (it < P10_KV) {
      int dir = it & 1, unit = it >> 1;
      int n = unit & 31, bh = unit >> 5, hh = bh & 3;
      float lg = log_sigmoid(dir ? p.c_decay_b[hh] : p.c_decay_f[hh]) * LOG2E;
      LoadStrided al{(const bf16_t*)(p.ws + OFF_RVT) + (size_t)bh * 128 * 4096 + n * 128};
      LoadKtScaled bl{(const bf16_t*)(p.ws + OFF_RKT) + (size_t)bh * 128 * 4096 + n * 128, lg, dir};
      EpKV ep{(bf16_t*)(p.ws + (dir ? OFF_KVB : OFF_KVF)) + (size_t)unit * 16384};
      gemm_tile(al, bl, ep, 128, smem);
    } else {
      hyena_pre_tile(p, it - P10_KV, smem);
    }
  }
}

DI void retention_scan_item(const Params& p, int item) {
  const int per_dir = 32 * 8192 / 256;
  int dir = item / per_dir, j = item - dir * per_dir;
  int idx2 = j * 256 + tidx();
  int bh = idx2 >> 13, e2 = idx2 & 8191, hh = bh & 3;
  float lg = log_sigmoid(dir ? p.c_decay_b[hh] : p.c_decay_f[hh]) * LOG2E;
  float G = ex2(128.f * lg);
  unsigned* base = (unsigned*)(p.ws + (dir ? OFF_KVB : OFF_KVF)) + (size_t)bh * 32 * 8192 + e2;
  float s0 = 0.f, s1 = 0.f;
  if (!dir) {
    for (int n = 0; n < 32; ++n) {
      unsigned v = base[(size_t)n * 8192];
      base[(size_t)n * 8192] = pack2(s0, s1);
      s0 = G * s0 + bflo(v); s1 = G * s1 + bfhi(v);
    }
  } else {
    for (int n = 31; n >= 0; --n) {
      unsigned v = base[(size_t)n * 8192];
      base[(size_t)n * 8192] = pack2(s0, s1);
      s0 = G * s0 + bflo(v); s1 = G * s1 + bfhi(v);
    }
  }
}

DI void hyena_conv_unit(const Params& p, int item, char* smem) {
  const int tid = tidx(), lane = tid & 63, w = tid >> 6;
  const int c = item >> 1, bh2 = item & 1, b = bh2 * 4 + w;
  bf16_t* sG0 = (bf16_t*)smem;
  bf16_t* sG1 = sG0 + 8200;
  bf16_t* sU = sG1 + 8200;
  const bf16_t* G = (const bf16_t*)(p.ws + OFF_FILT) + (size_t)c * 8192;
  __syncthreads();
  for (int x = tid; x < 8192; x += 256) {
    bf16_t v = G[8191 - x];
    sG0[x] = v;
    if (x >= 1) sG1[x - 1] = v;
  }
  if (tid == 0) sG1[8191] = 0;
  {
    const bf16_t* ub = (const bf16_t*)(p.hbuf + HB_UT) + ((size_t)c * 8 + b) * 4096;
    bf16_t* su = sU + w * 64 * 72;
#pragma unroll
    for (int i = 0; i < 8; ++i) { int id = lane + 64 * i; int row = id >> 3, ck = id & 7; *(u32x4*)(su + row * 72 + ck * 8) = ldg16(ub + row * 64 + ck * 8); }
  }
  __syncthreads();
  const int n = lane & 15, g = lane >> 4;
  const bf16_t* su = sU + w * 64 * 72;
  f32x4 acc[4][4];
#pragma unroll
  for (int i = 0; i < 4; ++i)
#pragma unroll
    for (int j = 0; j < 4; ++j) { acc[i][j][0] = 0.f; acc[i][j][1] = 0.f; acc[i][j][2] = 0.f; acc[i][j][3] = 0.f; }
  auto bfrag = [&](int E) -> u32x4 {
    int a = 4095 - 16 * E - n + 8 * g;
    const bf16_t* src = (a & 1) ? (sG1 + (a - 1)) : (sG0 + a);
    const unsigned* s32 = (const unsigned*)src;
    u32x4 o = {s32[0], s32[1], s32[2], s32[3]};
    return o;
  };
  for (int d = -63; d <= 63; ++d) {
#pragma unroll
    for (int kk = 0; kk < 2; ++kk) {
      u32x4 bfr[4];
#pragma unroll
      for (int nn = 0; nn < 4; ++nn) bfr[nn] = bfrag(4 * d + nn - 2 * kk);
#pragma unroll
      for (int rb = 0; rb < 4; ++rb) {
        if (d >= 16 * rb - 63 && d <= 16 * rb + 15) {
          int t1 = 16 * rb + n, s1 = t1 - d;
          u32x4 a = zero4();
          if (s1 >= 0 && s1 < 64) a = *(const u32x4*)(su + s1 * 72 + 32 * kk + 8 * g);
#pragma unroll
          for (int nn = 0; nn < 4; ++nn) acc[rb][nn] = MFMA16(a, bfr[nn], acc[rb][nn]);
        }
      }
    }
  }
  bf16_t* yT = (bf16_t*)(p.hbuf + HB_YT) + ((size_t)c * 8 + b) * 4096;
#pragma unroll
  for (int rb = 0; rb < 4; ++rb)
#pragma unroll
    for (int nn = 0; nn < 4; ++nn)
#pragma unroll
      for (int q = 0; q < 4; ++q) yT[(16 * rb + 4 * g + q) * 64 + 16 * nn + n] = f2bf(acc[rb][nn][q]);
}

constexpr int P11_SCAN = 2 * (32 * 8192 / 256), P11_CONV = 1024;
DI void phase11(const Params& p, char* smem) {
  for (int it = vbid(); it < P11_CONV + P11_SCAN; it += vgrid()) {
    if (it < P11_CONV) hyena_conv_unit(p, it, smem);
    else retention_scan_item(p, it - P11_CONV);
  }
}

DI void stage_tile128(bf16_t* sT, const bf16_t* __restrict__ src, size_t ld, bool perm) {
  const int tid = tidx();
  __syncthreads();
#pragma unroll
  for (int hlf = 0; hlf < 2; ++hlf) {
    u32x4 regs[4];
#pragma unroll
    for (int i = 0; i < 4; ++i) { int id = tid + 256 * (4 * hlf + i); int row = id >> 4, ck = id & 15; regs[i] = ldg16(src + (size_t)row * ld + ck * 8); }
#pragma unroll
    for (int i = 0; i < 4; ++i) {
      int id = tid + 256 * (4 * hlf + i); int row = id >> 4, ck = id & 15;
      if (!perm) *(u32x4*)(sT + row * 136 + ck * 8) = regs[i];
      else {
        int g = ck >> 1, odd = ck & 1;
        u32x2 lo = {regs[i][0], regs[i][1]}, hi = {regs[i][2], regs[i][3]};
        *(u32x2*)(sT + row * 136 + g * 16 + (odd ? 4 : 0)) = lo;
        *(u32x2*)(sT + row * 136 + g * 16 + (odd ? 12 : 8)) = hi;
      }
    }
  }
  __syncthreads();
}

DI void load_qf8(const bf16_t* __restrict__ qp, u32x4* qf) {
#pragma unroll
  for (int ds = 0; ds < 8; ++ds) qf[ds] = ldg16(qp + 16 * ds);
}
DI void retention_out_unit(const Params& p, int unit, char* smem) {
  const int tid = tidx(), lane = tid & 63, w = tid >> 6, r = lane & 31, h = lane >> 5;
  const int n = unit & 31, bh = unit >> 5, hh = bh & 3, b = bh >> 2;
  const size_t tok0 = (size_t)b * 4096 + n * 128;
  bf16_t* sT = (bf16_t*)smem;
  const float lgf = log_sigmoid(p.c_decay_f[hh]) * LOG2E, lgb = log_sigmoid(p.c_decay_b[hh]) * LOG2E;
  const bf16_t* qp = (const bf16_t*)(p.ws + OFF_RQ) + (tok0 + 32 * w + r) * 512 + hh * 128 + 8 * h;
  int cq = 32 * w + r;
  asm volatile("" : "+v"(cq));
  stage_tile128(sT, (const bf16_t*)(p.ws + OFF_RK) + tok0 * 512 + hh * 128, 512, false);
  u32x4 pf[8];
  {
    u32x4 qf[8];
    load_qf8(qp, qf);
#pragma unroll
    for (int mb = 0; mb < 4; ++mb) {
      f32x16 s;
#pragma unroll
      for (int q = 0; q < 16; ++q) s[q] = 0.f;
      const bf16_t* cK = sT + (32 * mb + r) * 136 + 8 * h;
#pragma unroll
      for (int ds = 0; ds < 8; ++ds) { u32x4 k = *(const u32x4*)(cK + 16 * ds); s = MFMA32(k, qf[ds], s); }
#pragma unroll
      for (int q = 0; q < 16; ++q) {
        int m = 32 * mb + crow(q, h);
        int diff = cq - m;
        float dec = (diff >= 0) ? ex2((float)diff * lgf) : ex2((float)(-diff) * lgb);
        s[q] *= dec;
      }
#pragma unroll
      for (int sx = 0; sx < 2; ++sx) {
        pf[2 * mb + sx][0] = pack2(s[8 * sx], s[8 * sx + 1]); pf[2 * mb + sx][1] = pack2(s[8 * sx + 2], s[8 * sx + 3]);
        pf[2 * mb + sx][2] = pack2(s[8 * sx + 4], s[8 * sx + 5]); pf[2 * mb + sx][3] = pack2(s[8 * sx + 6], s[8 * sx + 7]);
      }
    }
  }
  stage_tile128(sT, (const bf16_t*)(p.ws + OFF_RVT) + (size_t)bh * 128 * 4096 + n * 128, 4096, true);
  f32x16 o[4];
#pragma unroll
  for (int eb = 0; eb < 4; ++eb) {
#pragma unroll
    for (int q = 0; q < 16; ++q) o[eb][q] = 0.f;
    const bf16_t* cV = sT + (32 * eb + r) * 136 + 8 * h;
#pragma unroll
    for (int ks = 0; ks < 8; ++ks) { u32x4 v = *(const u32x4*)(cV + 16 * ks); o[eb] = MFMA32(v, pf[ks], o[eb]); }
  }
#pragma unroll 1
  for (int dir = 0; dir < 2; ++dir) {
    stage_tile128(sT, (const bf16_t*)(p.ws + (dir ? OFF_KVB : OFF_KVF)) + (size_t)unit * 16384, 128, false);
    u32x4 qf[8];
    load_qf8(qp, qf);
    const float xi = dir ? ex2((float)(128 - cq) * lgb) : ex2((float)(cq + 1) * lgf);
#pragma unroll
    for (int eb = 0; eb < 4; ++eb) {
      f32x16 t;
#pragma unroll
      for (int q = 0; q < 16; ++q) t[q] = 0.f;
      const bf16_t* cS = sT + (32 * eb + r) * 136 + 8 * h;
#pragma unroll
      for (int ds = 0; ds < 8; ++ds) { u32x4 sv = *(const u32x4*)(cS + 16 * ds); t = MFMA32(sv, qf[ds], t); }
#pragma unroll
      for (int q = 0; q < 16; ++q) o[eb][q] += xi * t[q];
    }
  }
  float ss = 0.f;
#pragma unroll
  for (int eb = 0; eb < 4; ++eb)
#pragma unroll
    for (int q = 0; q < 16; ++q) ss += o[eb][q] * o[eb][q];
  ss += __shfl_xor(ss, 32);
  const float rn = rsqrtf(ss * (1.f / 128.f) + EPS);
  const bf16_t* gp = (const bf16_t*)(p.ws + OFF_RG) + (tok0 + cq) * 512 + hh * 128;
  bf16_t* op = (bf16_t*)(p.ws + OFF_AB) + (tok0 + cq) * 1024 + hh * 128;
#pragma unroll
  for (int eb = 0; eb < 4; ++eb)
#pragma unroll
    for (int g4 = 0; g4 < 4; ++g4) {
      int e = 32 * eb + 8 * g4 + 4 * h;
      u32x2 gu = *(const u32x2*)(gp + e);
      float gv[4] = {bflo(gu[0]), bfhi(gu[0]), bflo(gu[1]), bfhi(gu[1])};
      float ov[4];
#pragma unroll
      for (int q = 0; q < 4; ++q) { float gg = gv[q]; float sl = gg * __builtin_amdgcn_rcpf(1.f + __expf(-gg)); ov[q] = o[eb][4 * g4 + q] * rn * sl; }
      u32x2 st = {pack2(ov[0], ov[1]), pack2(ov[2], ov[3])};
      *(u32x2*)(op + e) = st;
    }
}

DI void hyena_post_tile(const Params& p, int item, char* smem) {
  const int tid = tidx();
  const int ct = item & 7, st = (item >> 3) & 63, b = item >> 9;
  const bf16_t* HY = (const bf16_t*)(p.ws + OFF_HY) + (size_t)b * 4096 * 1536;
  const bf16_t* yT = (const bf16_t*)(p.hbuf + HB_YT);
  bf16_t* sT = (bf16_t*)smem;
  __syncthreads();
#pragma unroll
  for (int i = 0; i < 2; ++i) {
    int row = (tid >> 3) + 32 * i, ck = tid & 7;
    u32x4 u = ldg16(yT + ((size_t)(ct * 64 + row) * 8 + b) * 4096 + st * 64 + ck * 8);
#pragma unroll
    for (int j = 0; j < 8; ++j) { unsigned wv = u[j >> 1]; sT[(ck * 8 + j) * 72 + row] = (bf16_t)((j & 1) ? (wv >> 16) : (wv & 0xffffu)); }
  }
  __syncthreads();
  bf16_t* CD = (bf16_t*)(p.ws + OFF_AB);
#pragma unroll
  for (int i = 0; i < 2; ++i) {
    int row = (tid >> 3) + 32 * i, ck = tid & 7, s = st * 64 + row, c = ct * 64 + ck * 8;
    float x0[8];
#pragma unroll
    for (int j = 0; j < 8; ++j) x0[j] = 0.f;
#pragma unroll
    for (int d = -1; d <= 1; ++d) {
      int ss = s + d;
      if (ss >= 0 && ss < 4096) {
        u32x4 a = ldg16(HY + (size_t)ss * 1536 + c);
        float wa[8]; ld8f(p.c_short + (d + 1) * 1536 + c, wa);
#pragma unroll
        for (int q = 0; q < 4; ++q) { x0[2 * q] += wa[2 * q] * bflo(a[q]); x0[2 * q + 1] += wa[2 * q + 1] * bfhi(a[q]); }
      }
    }
    u32x4 y = *(const u32x4*)(sT + row * 72 + ck * 8);
    float v[8];
#pragma unroll
    for (int q = 0; q < 4; ++q) { v[2 * q] = bflo(y[q]) * x0[2 * q]; v[2 * q + 1] = bfhi(y[q]) * x0[2 * q + 1]; }
    store8(CD + ((size_t)b * 4096 + s) * 1024 + 512 + c, v);
  }
}

constexpr int P12_RET = 1024, P12_HY = 4096;
DI void phase12(const Params& p, char* smem) {
  for (int it = vbid(); it < P12_RET + P12_HY; it += vgrid()) {
    if (it < P12_RET) retention_out_unit(p, it, smem);
    else hyena_post_tile(p, it - P12_RET, smem);
  }
}

constexpr int NPHASE = 18;
DI void run_phase(const Sched& sc, const Params& p, int ph, char* smem_full) {
  char* ws = p.ws;
  char* smem = smem_full + vhalf() * SMEM_HALF;
  bf16_t* H = (bf16_t*)(p.hbuf);
  bf16_t* XB = (bf16_t*)(ws + OFF_H);
  bf16_t* AB = (bf16_t*)(ws + OFF_AB);
  bf16_t* M = (bf16_t*)(ws + OFF_M);
  bf16_t* HID = (bf16_t*)(ws + OFF_HID);
  switch (ph) {
    case 0: phase0(p, smem); break;
    case 1: phase_gemm_plain256(sc, H, 1024, (const bf16_t*)(ws + OFF_WT_IN0), 1024, 1952, (bf16_t*)(ws + OFF_P), 1952, smem_full); break;
    case 2: phase2(p, smem); break;
    case 3: phase3(sc, p, smem_full); break;
    case 4: phase_gemm_plain256(sc, AB, 1024, (const bf16_t*)(ws + OFF_WT_OUT0), 1024, 1024, M, 1024, smem_full); break;
    case 5: phase_resid<0, 1>(p.x, XB, M, p.mix_post, p.ffn_pre, H); break;
    case 6: phase_ffn_up256(sc, p, 0, smem_full); break;
    case 7: phase_gemm_plain256(sc, HID, DFF, (const bf16_t*)(ws + OFF_WT_DN0), DFF, 1024, M, 1024, smem_full); break;
    case 8: phase_resid<1, 1>(XB, XB, M, p.ffn_post, p.mix_pre + 1024, H); break;
    case 9: phase_in1_256(sc, p, smem_full); break;
    case 10: phase10(p, smem); break;
    case 11: phase11(p, smem); break;
    case 12: phase12(p, smem); break;
    case 13: phase_gemm_plain256(sc, AB, 1024, (const bf16_t*)(ws + OFF_WT_OUT1), 1024, 1024, M, 1024, smem_full); break;
    case 14: phase_resid<1, 1>(XB, XB, M, p.mix_post + 1024, p.ffn_pre + 1024, H); break;
    case 15: phase_ffn_up256(sc, p, 1, smem_full); break;
    case 16: phase_gemm_plain256(sc, HID, DFF, (const bf16_t*)(ws + OFF_WT_DN1), DFF, 1024, M, 1024, smem_full); break;
    case 17: phase_resid<1, 0>(XB, p.out, M, p.ffn_post + 1024, nullptr, nullptr); break;
    default: break;
  }
}

#if MEGA
#define BW(i) ((i) * 64)
DI unsigned ba_ld(unsigned* p) { return __hip_atomic_load(p, __ATOMIC_RELAXED, __HIP_MEMORY_SCOPE_AGENT); }
DI unsigned ba_add(unsigned* p, unsigned v) { return __hip_atomic_fetch_add(p, v, __ATOMIC_RELAXED, __HIP_MEMORY_SCOPE_AGENT); }
struct GridBar { unsigned* bar; unsigned x, nloc, nx, k; };
DI void gbar_spin(unsigned* p, unsigned target, unsigned* tmo) {
  unsigned sp = 0;
  while (ba_ld(p) < target) {
    if ((++sp & 1023u) == 0u) { if (ba_ld(tmo)) break; if (sp > (1u << 23)) { ba_add(tmo, 1u); break; } }
  }
}
DI void gbar(GridBar& b) {
  asm volatile("s_waitcnt vmcnt(0)" ::: "memory");
  __syncthreads();
  b.k++;
  if (tid512() == 0) {
    unsigned* bar = b.bar;
    unsigned old = ba_add(&bar[BW(16 + b.x)], 1u);
    if (old + 1u == b.k * b.nloc) {
      __builtin_amdgcn_fence(__ATOMIC_RELEASE, "agent");
      asm volatile("s_waitcnt vmcnt(0)" ::: "memory");
      ba_add(&bar[BW(48)], 1u);
      gbar_spin(&bar[BW(48)], b.k * b.nx, &bar[BW(49)]);
      __hip_atomic_store(&bar[BW(32 + b.x)], b.k, __ATOMIC_RELAXED, __HIP_MEMORY_SCOPE_AGENT);
    } else {
      gbar_spin(&bar[BW(32 + b.x)], b.k, &bar[BW(49)]);
    }
    __builtin_amdgcn_fence(__ATOMIC_ACQUIRE, "agent");
    asm volatile("s_waitcnt vmcnt(0)" ::: "memory");
  }
  __syncthreads();
}
template <int PH>
DI void mega_phases(const Sched& sc, const Params& p, char* smem, GridBar& gb) {
  if constexpr (PH == 7 || PH == 16) { ffn_fixup(p, PH == 16 ? 1 : 0); gbar(gb); }
  run_phase(sc, p, PH, smem);
  if constexpr (((DUP_MASK >> PH) & 1) != 0) { gbar(gb); run_phase(sc, p, PH, smem); }
  if constexpr (PH + 1 < NPHASE) { gbar(gb); if (DUP_SYNC) gbar(gb); mega_phases<PH + 1>(sc, p, smem, gb); }
}
__global__ void __launch_bounds__(512, 2) k_mega(Params p) {
  __shared__ __attribute__((aligned(16))) char smem[SMEM_TOTAL];
  cg::grid_group grid = cg::this_grid();
  GridBar gb;
  gb.bar = (unsigned*)(p.ws + OFF_BAR);
  gb.x = (unsigned)__builtin_amdgcn_s_getreg((3 << 11) | 20) & 0xFu;
  gb.k = 0;
  __shared__ int s_rank;
  if (tid512() == 0) s_rank = (int)ba_add(&gb.bar[BW(gb.x)], 1u);
  Sched sc{0, 1, 0, 1};
  run_phase(sc, p, 0, smem);
  grid.sync();
  {
    unsigned nx = 0, xs = 0, minloc = 0xffffffffu;
    for (int j = 0; j < 16; ++j) {
      unsigned c = ba_ld(&gb.bar[BW(j)]);
      if (c != 0u) { nx++; if ((unsigned)j < gb.x) xs++; minloc = c < minloc ? c : minloc; }
    }
    gb.nx = nx; gb.nloc = ba_ld(&gb.bar[BW(gb.x)]);
    sc.xs = (int)xs; sc.nx = (int)nx; sc.minloc = (int)minloc; sc.rank = __builtin_amdgcn_readfirstlane(s_rank);
  }
  mega_phases<1>(sc, p, smem, gb);
}
#endif

template <int PH>
__global__ void __launch_bounds__(512, 2) k_phase(Params p) {
  __shared__ __attribute__((aligned(16))) char smem[SMEM_TOTAL];
  Sched sc{(int)(blockIdx.x & 7), 8, (int)(blockIdx.x >> 3), (int)(gridDim.x >> 3)};
  if constexpr (PH == 7 || PH == 16) { ffn_fixup(p, PH == 16 ? 1 : 0); __threadfence(); }
  run_phase(sc, p, PH, smem);
}
template <int PH>
static void launch_phases(const Params& p, hipStream_t stream) {
  hipLaunchKernelGGL(k_phase<PH>, dim3(256), dim3(512), 0, stream, p);
  if constexpr (PH + 1 < NPHASE) launch_phases<PH + 1>(p, stream);
}

extern "C" void kernel_launch(void* const* d_in, const int* in_sizes, int n_in, void* d_out, int out_size, void* d_ws, size_t ws_size,
                              hipStream_t stream) {
  Params p{};
  const float** f = (const float**)&p;
  for (int i = 0; i < 30; ++i) f[i] = (const float*)d_in[i];
  p.out = (float*)d_out;
  p.ws = (char*)d_ws;
  p.hbuf = (char*)d_out + (size_t)T * 1024 * 2;
#if MEGA
  static int grid_blocks = 0;
  if (!grid_blocks) {
    int dev = 0, cus = 0, per_cu = 0;
    hipGetDevice(&dev);
    hipDeviceGetAttribute(&cus, hipDeviceAttributeMultiprocessorCount, dev);
    hipOccupancyMaxActiveBlocksPerMultiprocessor(&per_cu, k_mega, 512, 0);
    if (per_cu > 1) per_cu = 1;
    grid_blocks = cus * per_cu;
  }
  hipMemsetAsync((char*)d_ws + OFF_BAR, 0, BAR_BYTES, stream);
  void* args[] = {&p};
  hipError_t e = hipLaunchCooperativeKernel((void*)k_mega, dim3(grid_blocks), dim3(512), args, 0, stream);
  if (e != hipSuccess) fprintf(stderr, "cooperative launch failed: %s (grid %d)\n", hipGetErrorString(e), grid_blocks);
#else
  launch_phases<0>(p, stream);
#endif
}
```

```cpp
#include <hip/hip_runtime.h>
#include <hip/hip_cooperative_groups.h>
#include <stdint.h>
#include <stdio.h>
namespace cg = cooperative_groups;

#ifndef DUP_MASK
#define DUP_MASK 0u
#endif
#ifndef DUP_SYNC
#define DUP_SYNC 0
#endif
#ifndef MEGA
#define MEGA 1
#endif

#define DI __device__ __forceinline__
typedef unsigned short bf16_t;
typedef __attribute__((ext_vector_type(8))) short bf16x8;
typedef __attribute__((ext_vector_type(16))) float f32x16;
typedef __attribute__((ext_vector_type(4))) float f32x4;
typedef __attribute__((ext_vector_type(4))) unsigned u32x4;
typedef __attribute__((ext_vector_type(2))) unsigned u32x2;
typedef __bf16 bf2_t __attribute__((ext_vector_type(2)));
typedef float f2_t __attribute__((ext_vector_type(2)));

#define MFMA32(a, b, c) __builtin_amdgcn_mfma_f32_32x32x16_bf16(__builtin_bit_cast(bf16x8, (a)), __builtin_bit_cast(bf16x8, (b)), (c), 0, 0, 0)
#define MFMA16(a, b, c) __builtin_amdgcn_mfma_f32_16x16x32_bf16(__builtin_bit_cast(bf16x8, (a)), __builtin_bit_cast(bf16x8, (b)), (c), 0, 0, 0)

constexpr int T = 32768, S = 4096, NBATCH = 8, DM = 1024, DFF = 2816;
constexpr float EPS = 1e-6f;
constexpr float LOG2E = 1.4426950408889634f;

DI int threadIdx_x_raw() { return (int)__builtin_amdgcn_workitem_id_x(); }
DI unsigned pack2(float a, float b) { f2_t f = {a, b}; bf2_t r = __builtin_convertvector(f, bf2_t); return __builtin_bit_cast(unsigned, r); }
DI float bflo(unsigned u) { return __uint_as_float(u << 16); }
DI float bfhi(unsigned u) { return __uint_as_float(u & 0xffff0000u); }
DI float bf2f(bf16_t v) { return __uint_as_float(((unsigned)v) << 16); }
DI bf16_t f2bf(float x) { return (bf16_t)(pack2(x, 0.f) & 0xffffu); }
DI float ex2(float x) { return __builtin_amdgcn_exp2f(x); }
DI int tid512() { int t = threadIdx_x_raw(); asm volatile("" : "+v"(t)); return t; }
DI int tidx() { return tid512() & 255; }
DI int vhalf() { return __builtin_amdgcn_readfirstlane(threadIdx_x_raw() >> 8); }
DI int vbid() { return 2 * (int)blockIdx.x + vhalf(); }
DI int vgrid() { return 2 * (int)gridDim.x; }
DI int crow(int reg, int h) { return (reg & 3) + 8 * (reg >> 2) + 4 * h; }
DI u32x4 ldg16(const void* p) { return *(const u32x4*)p; }
DI u32x4 zero4() { u32x4 z = {0u, 0u, 0u, 0u}; return z; }
DI int clampi(int v, int lo, int hi) { return v < lo ? lo : (v > hi ? hi : v); }

constexpr size_t SZ_WT_IN0 = (size_t)1952 * 1024 * 2, SZ_WT_QUP = (size_t)768 * 256 * 2, SZ_WT_KVUP = (size_t)1024 * 128 * 2,
                 SZ_WT_SQ = (size_t)1024 * 1024 * 2, SZ_WT_GU = (size_t)5632 * 1024 * 2, SZ_WT_DOWN = (size_t)1024 * 2816 * 2,
                 SZ_WT_IN1 = (size_t)3584 * 1024 * 2, SZ_ROPEA = (size_t)4096 * 16 * 8, SZ_ROPER = (size_t)4096 * 64 * 8,
                 SZ_FILT = (size_t)512 * 8192 * 2;
constexpr size_t OFF_WT_IN0 = 0;
constexpr size_t OFF_WT_QUP = OFF_WT_IN0 + SZ_WT_IN0;
constexpr size_t OFF_WT_KVUP = OFF_WT_QUP + SZ_WT_QUP;
constexpr size_t OFF_WT_OUT0 = OFF_WT_KVUP + SZ_WT_KVUP;
constexpr size_t OFF_WT_GU0 = OFF_WT_OUT0 + SZ_WT_SQ;
constexpr size_t OFF_WT_GU1 = OFF_WT_GU0 + SZ_WT_GU;
constexpr size_t OFF_WT_DN0 = OFF_WT_GU1 + SZ_WT_GU;
constexpr size_t OFF_WT_DN1 = OFF_WT_DN0 + SZ_WT_DOWN;
constexpr size_t OFF_WT_IN1 = OFF_WT_DN1 + SZ_WT_DOWN;
constexpr size_t OFF_WT_OUT1 = OFF_WT_IN1 + SZ_WT_IN1;
constexpr size_t OFF_ROPEA = OFF_WT_OUT1 + SZ_WT_SQ;
constexpr size_t OFF_ROPER = OFF_ROPEA + SZ_ROPEA;
constexpr size_t OFF_FILT = OFF_ROPER + SZ_ROPER;
constexpr size_t OFF_H = OFF_FILT + SZ_FILT;
constexpr size_t SZ_H = (size_t)T * 1024 * 2;
constexpr size_t OFF_AB = OFF_H + SZ_H;
constexpr size_t OFF_R = OFF_AB + SZ_H;
constexpr size_t OFF_P = OFF_R;
constexpr size_t OFF_QM = OFF_P + (size_t)T * 1952 * 2;
constexpr size_t OFF_KF = OFF_QM + (size_t)T * 768 * 2;
constexpr size_t OFF_VTM = OFF_KF + (size_t)T * 768 * 2;
constexpr size_t OFF_VTN = OFF_VTM + (size_t)T * 512 * 2;
constexpr size_t END_L0 = OFF_VTN + (size_t)T * 512 * 2;
constexpr size_t OFF_HID = OFF_R;
constexpr size_t OFF_M = OFF_R + (size_t)T * 2816 * 2;
constexpr size_t END_FFN = OFF_M + SZ_H;
constexpr size_t OFF_RQ = OFF_R;
constexpr size_t OFF_RK = OFF_RQ + (size_t)T * 512 * 2;
constexpr size_t OFF_RKT = OFF_RK + (size_t)T * 512 * 2;
constexpr size_t OFF_RVT = OFF_RKT + (size_t)T * 512 * 2;
constexpr size_t OFF_RG = OFF_RVT + (size_t)T * 512 * 2;
constexpr size_t OFF_HY = OFF_RG + (size_t)T * 512 * 2;
constexpr size_t OFF_KVF = OFF_HY + (size_t)T * 1536 * 2;
constexpr size_t OFF_KVB = OFF_KVF + (size_t)1024 * 16384 * 2;
constexpr size_t END_L1 = OFF_KVB + (size_t)1024 * 16384 * 2;
constexpr size_t HB_UT = 0;
constexpr size_t HB_YT = (size_t)512 * 8 * 4096 * 2;
constexpr size_t WS_NEED = END_L1 > END_L0 ? (END_L1 > END_FFN ? END_L1 : END_FFN) : (END_L0 > END_FFN ? END_L0 : END_FFN);
constexpr size_t OFF_BAR = (WS_NEED + 255) & ~(size_t)255;
constexpr size_t BAR_BYTES = 64 * 256;
static_assert(OFF_BAR + BAR_BYTES <= (size_t)512 * 1024 * 1024, "workspace too large");

struct Params {
  const float *x, *mix_pre, *mix_post, *ffn_pre, *ffn_post, *w_gate, *w_up, *ffn_conv, *w_down;
  const float *a_w_in, *a_q_norm, *a_w_q_up, *a_kv_norm, *a_w_kv_up, *a_rpb, *a_w_out;
  const float *c_w_in, *c_decay_f, *c_decay_b, *c_short, *f_w1, *f_b1, *f_w2, *f_b2, *f_w3, *f_b3, *f_w4, *f_freq, *hy_bias, *c_w_out;
  float* out;
  char* ws;
  char* hbuf;
};

constexpr int SMEM_BYTES = 73728;

constexpr int GLD = 72;
constexpr int CLD = 132;
template <class AL, class BL, class EP>
DI void gemm_tile(AL al, BL bl, EP ep, int K, char* smem) {
  bf16_t* sA = (bf16_t*)smem;
  bf16_t* sB = sA + 2 * 128 * GLD;
  const int tid = tidx(), lane = tid & 63, w = tid >> 6, wm = w >> 1, wn = w & 1, r = lane & 31, h = lane >> 5;
  const int lrow = tid >> 3, lck = tid & 7;
  f32x16 acc[2][2];
#pragma unroll
  for (int i = 0; i < 2; ++i)
#pragma unroll
    for (int j = 0; j < 2; ++j)
#pragma unroll
      for (int q = 0; q < 16; ++q) acc[i][j][q] = 0.f;
  u32x4 ra0[4], rb0[4], ra1[4], rb1[4];
  const int KT = K >> 6;
#define G_LOAD(RA, RB, kt_) { _Pragma("unroll") for (int i = 0; i < 4; ++i) { RA[i] = al(lrow + 32 * i, (kt_) * 64 + lck * 8); RB[i] = bl(lrow + 32 * i, (kt_) * 64 + lck * 8); } }
#define G_STORE(RA, RB, buf_) { bf16_t* nA = sA + (buf_) * 128 * GLD; bf16_t* nB = sB + (buf_) * 128 * GLD; _Pragma("unroll") for (int i = 0; i < 4; ++i) { \
      *(u32x4*)(nA + (lrow + 32 * i) * GLD + lck * 8) = RA[i]; *(u32x4*)(nB + (lrow + 32 * i) * GLD + lck * 8) = RB[i]; } }
#define G_COMPUTE(buf_) { const bf16_t* cA = sA + (buf_) * 128 * GLD + (64 * wm + r) * GLD + 8 * h; const bf16_t* cB = sB + (buf_) * 128 * GLD + (64 * wn + r) * GLD + 8 * h; \
    _Pragma("unroll") for (int ks = 0; ks < 4; ++ks) { \
      u32x4 a0 = *(const u32x4*)(cA + ks * 16); u32x4 a1 = *(const u32x4*)(cA + 32 * GLD + ks * 16); \
      u32x4 b0 = *(const u32x4*)(cB + ks * 16); u32x4 b1 = *(const u32x4*)(cB + 32 * GLD + ks * 16); \
      acc[0][0] = MFMA32(a0, b0, acc[0][0]); acc[0][1] = MFMA32(a0, b1, acc[0][1]); \
      acc[1][0] = MFMA32(a1, b0, acc[1][0]); acc[1][1] = MFMA32(a1, b1, acc[1][1]); } }
  G_LOAD(ra0, rb0, 0);
  if (KT > 1) G_LOAD(ra1, rb1, 1);
  __syncthreads();
  G_STORE(ra0, rb0, 0);
  __syncthreads();
  for (int kt = 0; kt < KT; kt += 2) {
    if (kt + 2 < KT) G_LOAD(ra0, rb0, kt + 2);
    __builtin_amdgcn_sched_barrier(0);
    G_COMPUTE(0);
    __builtin_amdgcn_sched_barrier(0);
    if (kt + 1 < KT) G_STORE(ra1, rb1, 1);
    __syncthreads();
    if (kt + 1 >= KT) break;
    if (kt + 3 < KT) G_LOAD(ra1, rb1, kt + 3);
    __builtin_amdgcn_sched_barrier(0);
    G_COMPUTE(1);
    __builtin_amdgcn_sched_barrier(0);
    if (kt + 2 < KT) G_STORE(ra0, rb0, 0);
    __syncthreads();
  }
#undef G_LOAD
#undef G_STORE
#undef G_COMPUTE
  float* sC = (float*)smem;
#pragma unroll
  for (int i = 0; i < 2; ++i)
#pragma unroll
    for (int j = 0; j < 2; ++j)
#pragma unroll
      for (int q = 0; q < 16; ++q) sC[(64 * wm + 32 * i + crow(q, h)) * CLD + 64 * wn + 32 * j + r] = acc[i][j][q];
  __syncthreads();
  ep(sC);
}

struct Sched { int xs, nx, rank, minloc; };
DI int sched_tile(const Sched& sc, int round, int MT, int NT, int& mt, int& nt) {
  const int total = MT * NT;
  const int per = (total + sc.nx - 1) / sc.nx;
  const int off = round * sc.minloc;
  if (off >= per) return 2;
  if (sc.rank >= sc.minloc) return 1;
  int L = off + sc.rank;
  if (L >= per) return 1;
  L += sc.xs * per;
  if (L >= total) return 1;
  for (int c0 = 0; c0 < NT; c0 += 8) {
    const int w = NT - c0 < 8 ? NT - c0 : 8;
    const int cnt = MT * w;
    if (L < cnt) { mt = L / w; nt = c0 + L - mt * w; return 0; }
    L -= cnt;
  }
  return 1;
}

constexpr int BLD = 264;
constexpr int SMEM_HALF = 73728;
constexpr int SMEM_TOTAL = 2 * SMEM_HALF;
template <class AL, class BL, class EP>
DI void gemm_tile256(AL al, BL bl, EP ep, int K, char* smem) {
  bf16_t* sA = (bf16_t*)smem;
  bf16_t* sB = sA + 2 * 256 * GLD;
  const int tid = tid512(), lane = tid & 63, w = tid >> 6, wm = w >> 2, wn = w & 3, r = lane & 31, h = lane >> 5;
  const int lrow = tid >> 3, lck = tid & 7;
  f32x16 acc[4][2];
#pragma unroll
  for (int i = 0; i < 4; ++i)
#pragma unroll
    for (int j = 0; j < 2; ++j)
#pragma unroll
      for (int q = 0; q < 16; ++q) acc[i][j][q] = 0.f;
  u32x4 ra[4], rb[4];
  const int KT = K >> 6;
#define G_LOADA(kt_) { _Pragma("unroll") for (int i = 0; i < 4; ++i) ra[i] = al(lrow + 64 * i, (kt_) * 64 + lck * 8); }
#define G_LOADB(kt_) { _Pragma("unroll") for (int i = 0; i < 4; ++i) rb[i] = bl(lrow + 64 * i, (kt_) * 64 + lck * 8); }
#define G_STOREA(buf_) { bf16_t* nA = sA + (buf_) * 256 * GLD; _Pragma("unroll") for (int i = 0; i < 4; ++i) *(u32x4*)(nA + (lrow + 64 * i) * GLD + lck * 8) = ra[i]; }
#define G_STOREB(buf_) { bf16_t* nB = sB + (buf_) * 256 * GLD; _Pragma("unroll") for (int i = 0; i < 4; ++i) *(u32x4*)(nB + (lrow + 64 * i) * GLD + lck * 8) = rb[i]; }
#define G_COMPUTE_KS(buf_, ks) { const bf16_t* cA = sA + (buf_) * 256 * GLD + (128 * wm + r) * GLD + 8 * h; const bf16_t* cB = sB + (buf_) * 256 * GLD + (64 * wn + r) * GLD + 8 * h; \
      u32x4 b0 = *(const u32x4*)(cB + (ks) * 16); u32x4 b1 = *(const u32x4*)(cB + 32 * GLD + (ks) * 16); \
      _Pragma("unroll") for (int i = 0; i < 4; ++i) { u32x4 a = *(const u32x4*)(cA + 32 * i * GLD + (ks) * 16); \
        acc[i][0] = MFMA32(b0, a, acc[i][0]); acc[i][1] = MFMA32(b1, a, acc[i][1]); } }
#define G_STEP(cur_, kt_) { \
    if ((kt_) + 1 < KT) G_LOADA((kt_) + 1); \
    __builtin_amdgcn_sched_barrier(0); \
    G_COMPUTE_KS(cur_, 0); \
    __builtin_amdgcn_sched_barrier(0); \
    if ((kt_) + 1 < KT) G_STOREB((cur_) ^ 1); \
    if ((kt_) + 2 < KT) G_LOADB((kt_) + 2); \
    __builtin_amdgcn_sched_barrier(0); \
    G_COMPUTE_KS(cur_, 1); G_COMPUTE_KS(cur_, 2); \
    __builtin_amdgcn_sched_barrier(0); \
    if ((kt_) + 1 < KT) G_STOREA((cur_) ^ 1); \
    __builtin_amdgcn_sched_barrier(0); \
    G_COMPUTE_KS(cur_, 3); \
    __syncthreads(); }
  G_LOADA(0); G_LOADB(0);
  __syncthreads();
  G_STOREA(0); G_STOREB(0);
  if (KT > 1) G_LOADB(1);
  __syncthreads();
  for (int kt = 0; kt < KT; kt += 2) {
    G_STEP(0, kt);
    if (kt + 1 >= KT) break;
    G_STEP(1, kt + 1);
  }
#undef G_LOADA
#undef G_LOADB
#undef G_STOREA
#undef G_STOREB
#undef G_COMPUTE_KS
#undef G_STEP
  if constexpr (EP::kBf16) {
    bf16_t* sCb = (bf16_t*)smem;
#pragma unroll
    for (int i = 0; i < 4; ++i)
#pragma unroll
      for (int j = 0; j < 2; ++j)
#pragma unroll
        for (int g = 0; g < 4; ++g) {
          u32x2 v = {pack2(acc[i][j][4 * g], acc[i][j][4 * g + 1]), pack2(acc[i][j][4 * g + 2], acc[i][j][4 * g + 3])};
          *(u32x2*)(sCb + (128 * wm + 32 * i + r) * BLD + 64 * wn + 32 * j + 8 * g + 4 * h) = v;
        }
    __syncthreads();
    ep(sCb);
  } else {
    float* sC = (float*)smem;
#pragma unroll
    for (int pass = 0; pass < 2; ++pass) {
      if (pass) __syncthreads();
      if ((wn >> 1) == pass) {
#pragma unroll
        for (int i = 0; i < 4; ++i)
#pragma unroll
          for (int j = 0; j < 2; ++j)
#pragma unroll
            for (int g = 0; g < 4; ++g) {
              f32x4 v = {acc[i][j][4 * g], acc[i][j][4 * g + 1], acc[i][j][4 * g + 2], acc[i][j][4 * g + 3]};
              *(f32x4*)(sC + (128 * wm + 32 * i + r) * CLD + 64 * (wn & 1) + 32 * j + 8 * g + 4 * h) = v;
            }
      }
      __syncthreads();
      ep(sC, pass);
    }
  }
}

struct LoadRows {
  const bf16_t* base; int ld; int row0; int nrows;
  DI u32x4 operator()(int r, int k) const {
    int row = row0 + r;
    row = row < nrows ? row : nrows - 1;
    return ldg16(base + (size_t)row * ld + k);
  }
};

DI void store8(bf16_t* dst, const float* v) {
  u32x4 o; o[0] = pack2(v[0], v[1]); o[1] = pack2(v[2], v[3]); o[2] = pack2(v[4], v[5]); o[3] = pack2(v[6], v[7]);
  *(u32x4*)dst = o;
}
DI void ld8f(const float* s, float* v) {
  f32x4 a = *(const f32x4*)s, b = *(const f32x4*)(s + 4);
  v[0] = a[0]; v[1] = a[1]; v[2] = a[2]; v[3] = a[3]; v[4] = b[0]; v[5] = b[1]; v[6] = b[2]; v[7] = b[3];
}

DI void ld8b(const bf16_t* p, float* v) {
  u32x4 u = *(const u32x4*)p;
#pragma unroll
  for (int q = 0; q < 4; ++q) { v[2 * q] = bflo(u[q]); v[2 * q + 1] = bfhi(u[q]); }
}
struct EpStore {
  bf16_t* dst; int ld; int m0; int n0; int N;
  DI void operator()(const float* sC) const {
    for (int id = tidx(); id < 2048; id += 256) {
      int row = id >> 4, c8 = (id & 15) * 8;
      if (n0 + c8 < N) { float v[8]; ld8f(sC + row * CLD + c8, v); store8(dst + (size_t)(m0 + row) * ld + n0 + c8, v); }
    }
  }
};

DI void transpose_tile(const float* __restrict__ src, bf16_t* __restrict__ dst, int K, int N, const float* kscale, int mode, int tile, char* smem) {
  float* sm = (float*)smem;
  const int ntn = (N + 63) >> 6;
  const int tk = tile / ntn, tn = tile - tk * ntn, k0 = tk * 64, n0 = tn * 64, tid = tidx();
  __syncthreads();
#pragma unroll 4
  for (int i = 0; i < 16; ++i) {
    int k = (tid >> 6) + 4 * i, n = n0 + (tid & 63);
    float v = (n < N) ? src[(size_t)(k0 + k) * N + n] : 0.f;
    if (kscale) v *= kscale[k0 + k];
    sm[k * 65 + (tid & 63)] = v;
  }
  __syncthreads();
#pragma unroll
  for (int i = 0; i < 2; ++i) {
    int nl = (tid >> 3) + 32 * i, n = n0 + nl, kc = (tid & 7) * 8;
    if (n < N) {
      float v[8];
#pragma unroll
      for (int j = 0; j < 8; ++j) v[j] = sm[(kc + j) * 65 + nl];
      int drow = n;
      if (mode == 1) drow = (n >> 6) * 128 + (n & 63);
      if (mode == 2) drow = (n >> 6) * 128 + 64 + (n & 63);
      store8(dst + (size_t)drow * K + k0 + kc, v);
    }
  }
}

DI void rms_row_to_bf16(const float* __restrict__ xr, const float* __restrict__ g, bf16_t* __restrict__ hr, int lane) {
  f32x4 v[4]; float ss = 0.f;
#pragma unroll
  for (int i = 0; i < 4; ++i) { v[i] = *(const f32x4*)(xr + lane * 4 + 256 * i);     ss += v[i][0] * v[i][0] + v[i][1] * v[i][1] + v[i][2] * v[i][2] + v[i][3] * v[i][3]; }
#pragma unroll
  for (int o = 32; o >= 1; o >>= 1) ss += __shfl_xor(ss, o);
  float rs = rsqrtf(ss * (1.f / 1024.f) + EPS);
#pragma unroll
  for (int i = 0; i < 4; ++i) {
    f32x4 gg = *(const f32x4*)(g + lane * 4 + 256 * i);
    u32x2 o; o[0] = pack2(v[i][0] * rs * gg[0], v[i][1] * rs * gg[1]); o[1] = pack2(v[i][2] * rs * gg[2], v[i][3] * rs * gg[3]);
    *(u32x2*)(hr + lane * 4 + 256 * i) = o;
  }
}

DI void sincos_acc(float ang, float& c, float& s) {
  double a = (double)ang;
  double n = rint(a * 0.15915494309189535);
  float r = (float)(a - n * 6.283185307179586);
  c = cosf(r); s = sinf(r);
}

DI void hyena_filter_pos(const Params& p, int t, int w, int lane, float* sz, float* sh0, float* sh1) {
  const float tn = (float)t / 4095.f;
  const float wt = (6.283185307179586f * (float)t) / 4096.f;
  if (lane < 33) {
    float z;
    if (lane == 0) z = tn;
    else {
      int i = (lane - 1) & 15;
      float f = 1e-4f + (float)i * ((15.f - 1e-4f) / 15.f);
      float fw = f * wt;
      z = (lane <= 16) ? cosf(fw) : -sinf(fw);
    }
    sz[w * 40 + lane] = z;
  }
  __syncthreads();
  const float fr = p.f_freq[lane];
  float a = p.f_b1[lane];
#pragma unroll 1
  for (int i = 0; i < 33; ++i) a += sz[w * 40 + i] * p.f_w1[i * 64 + lane];
  sh0[w * 64 + lane] = sinf(fr * a);
  __syncthreads();
  a = p.f_b2[lane];
#pragma unroll 4
  for (int i = 0; i < 64; ++i) a += sh0[w * 64 + i] * p.f_w2[i * 64 + lane];
  sh1[w * 64 + lane] = sinf(fr * a);
  __syncthreads();
  a = p.f_b3[lane];
#pragma unroll 4
  for (int i = 0; i < 64; ++i) a += sh1[w * 64 + i] * p.f_w3[i * 64 + lane];
  __syncthreads();
  sh0[w * 64 + lane] = sinf(fr * a);
  __syncthreads();
  bf16_t* filt = (bf16_t*)(p.ws + OFF_FILT);
  const float dmin = logf(1e-2f) / 1.5f, dmax = logf(1e-2f) / 0.3f;
#pragma unroll 1
  for (int i = 0; i < 16; ++i) {
    int n = lane + 64 * i;
    float o = 0.f;
#pragma unroll 4
    for (int k = 0; k < 64; ++k) o += sh0[w * 64 + k] * p.f_w4[k * 1024 + n];
    int c = n & 511;
    float delta = dmin + (float)c * ((dmax - dmin) / 511.f);
    float win = expf(-tn * fabsf(delta));
    o *= win;
    if (n < 512) {
      if (t == 0) o += p.hy_bias[c];
      filt[(size_t)c * 8192 + 4096 + t] = f2bf(o);
    } else {
      if (t == 0) filt[(size_t)c * 8192] = 0;
      else filt[(size_t)c * 8192 + 4096 - t] = f2bf(o);
    }
  }
  __syncthreads();
}

constexpr int TR_T0 = 16 * 31, TR_T1 = 4 * 12, TR_T2 = 2 * 16, TR_T3 = 16 * 16, TR_TG = 16 * 44, TR_TD = 44 * 16, TR_TI1 = 16 * 56;
constexpr int TR_TOTAL = TR_T0 + TR_T1 + TR_T2 + TR_T3 + 4 * TR_TG + 2 * TR_TD + TR_TI1 + TR_T3;
constexpr int P0_ROPE = (4096 * 80) / 256;
constexpr int P0_FILT = 1024;
constexpr int P0_NORM = T / 4;
constexpr int P0_ITEMS = TR_TOTAL + P0_ROPE + P0_FILT + P0_NORM;

DI void phase0(const Params& p, char* smem) {
  const int tid = tidx(), lane = tid & 63, w = tid >> 6;
  for (int it = vbid(); it < P0_ITEMS; it += vgrid()) {
    if (it < TR_TOTAL) {
      int t = it;
      char* ws = p.ws;
      const float* src = p.a_w_in; size_t doff = OFF_WT_IN0; int K = 1024, N = 1952, mode = 0; const float* sc = nullptr;
      bool found = false;
      if (t < TR_T0) found = true; else t -= TR_T0;
      if (!found) { if (t < TR_T1) { found = true; src = p.a_w_q_up; doff = OFF_WT_QUP; K = 256; N = 768; sc = p.a_q_norm; } else t -= TR_T1; }
      if (!found) { if (t < TR_T2) { found = true; src = p.a_w_kv_up; doff = OFF_WT_KVUP; K = 128; N = 1024; sc = p.a_kv_norm; } else t -= TR_T2; }
      if (!found) { if (t < TR_T3) { found = true; src = p.a_w_out; doff = OFF_WT_OUT0; K = 1024; N = 1024; } else t -= TR_T3; }
      if (!found) { if (t < TR_TG) { found = true; src = p.w_gate; doff = OFF_WT_GU0; K = 1024; N = 2816; mode = 1; } else t -= TR_TG; }
      if (!found) { if (t < TR_TG) { found = true; src = p.w_gate + (size_t)1024 * 2816; doff = OFF_WT_GU1; K = 1024; N = 2816; mode = 1; } else t -= TR_TG; }
      if (!found) { if (t < TR_TG) { found = true; src = p.w_up; doff = OFF_WT_GU0; K = 1024; N = 2816; mode = 2; } else t -= TR_TG; }
      if (!found) { if (t < TR_TG) { found = true; src = p.w_up + (size_t)1024 * 2816; doff = OFF_WT_GU1; K = 1024; N = 2816; mode = 2; } else t -= TR_TG; }
      if (!found) { if (t < TR_TD) { found = true; src = p.w_down; doff = OFF_WT_DN0; K = 2816; N = 1024; } else t -= TR_TD; }
      if (!found) { if (t < TR_TD) { found = true; src = p.w_down + (size_t)1024 * 2816; doff = OFF_WT_DN1; K = 2816; N = 1024; } else t -= TR_TD; }
      if (!found) { if (t < TR_TI1) { found = true; src = p.c_w_in; doff = OFF_WT_IN1; K = 1024; N = 3584; } else t -= TR_TI1; }
      if (!found) { src = p.c_w_out; doff = OFF_WT_OUT1; K = 1024; N = 1024; }
      transpose_tile(src, (bf16_t*)(ws + doff), K, N, sc, mode, t, smem);
      continue;
    }
    int j = it - TR_TOTAL;
    if (j < P0_ROPE) {
      int idx = j * 256 + tid;
      if (idx < 4096 * 16) {
        int pos = idx >> 4, i = idx & 15;
        float inv = (float)exp2(-(double)(2 * i) / 32.0 * 13.287712379549449);
        float ang = (float)pos * inv, c, s; sincos_acc(ang, c, s);
        ((float2*)(p.ws + OFF_ROPEA))[idx] = make_float2(c, s);
      } else {
        int k = idx - 4096 * 16; int pos = k >> 6, i = k & 63;
        float inv = (float)exp2(-(double)(2 * i) / 128.0 * 13.287712379549449);
        float ang = (float)pos * inv, c, s; sincos_acc(ang, c, s);
        ((float2*)(p.ws + OFF_ROPER))[k] = make_float2(c, s);
      }
      continue;
    }
    j -= P0_ROPE;
    if (j < P0_FILT) {
      float* sf = (float*)smem;
      __syncthreads();
      hyena_filter_pos(p, j * 4 + w, w, lane, sf, sf + 160, sf + 160 + 256);
      continue;
    }
    j -= P0_FILT;
    {
      int row = j * 4 + w;
      rms_row_to_bf16(p.x + (size_t)row * 1024, p.mix_pre, (bf16_t*)(p.hbuf) + (size_t)row * 1024, lane);
    }
  }
}

template <int XIN, int XOUT>
DI void phase_resid(const void* xin_, void* xout_, const bf16_t* __restrict__ m, const float* __restrict__ gpost,
                    const float* __restrict__ gnext, bf16_t* __restrict__ hout) {
  const int lane = tidx() & 63, w = tidx() >> 6;
  for (int it = vbid(); it < T / 8; it += vgrid()) {
    const int row0 = it * 8 + w * 2;
    float mv[2][16], xv[2][16], ss[2], s2[2];
#pragma unroll
    for (int rr = 0; rr < 2; ++rr) {
      const size_t ro = (size_t)(row0 + rr) * 1024;
#pragma unroll
      for (int i = 0; i < 4; ++i) {
        u32x2 u = *(const u32x2*)(m + ro + lane * 4 + 256 * i);
        mv[rr][4 * i] = bflo(u[0]); mv[rr][4 * i + 1] = bfhi(u[0]); mv[rr][4 * i + 2] = bflo(u[1]); mv[rr][4 * i + 3] = bfhi(u[1]);
        if (XIN == 0) {
          f32x4 xo = __builtin_nontemporal_load((const f32x4*)((const float*)xin_ + ro + lane * 4 + 256 * i));
          xv[rr][4 * i] = xo[0]; xv[rr][4 * i + 1] = xo[1]; xv[rr][4 * i + 2] = xo[2]; xv[rr][4 * i + 3] = xo[3];
        } else {
          const u32x2* xp_ = (const u32x2*)((const bf16_t*)xin_ + ro + lane * 4 + 256 * i);
          u32x2 xu = (XOUT == 0) ? __builtin_nontemporal_load(xp_) : *xp_;
          xv[rr][4 * i] = bflo(xu[0]); xv[rr][4 * i + 1] = bfhi(xu[0]); xv[rr][4 * i + 2] = bflo(xu[1]); xv[rr][4 * i + 3] = bfhi(xu[1]);
        }
      }
    }
#pragma unroll
    for (int rr = 0; rr < 2; ++rr) {
      ss[rr] = 0.f;
#pragma unroll
      for (int q = 0; q < 16; ++q) ss[rr] += mv[rr][q] * mv[rr][q];
    }
#pragma unroll
    for (int o = 32; o >= 1; o >>= 1) { ss[0] += __shfl_xor(ss[0], o); ss[1] += __shfl_xor(ss[1], o); }
#pragma unroll
    for (int rr = 0; rr < 2; ++rr) {
      const size_t ro = (size_t)(row0 + rr) * 1024;
      const float rs = rsqrtf(ss[rr] * (1.f / 1024.f) + EPS);
      s2[rr] = 0.f;
#pragma unroll
      for (int i = 0; i < 4; ++i) {
        f32x4 gg = *(const f32x4*)(gpost + lane * 4 + 256 * i);
#pragma unroll
        for (int q = 0; q < 4; ++q) { float v = xv[rr][4 * i + q] + mv[rr][4 * i + q] * rs * gg[q]; xv[rr][4 * i + q] = v; s2[rr] += v * v; }
        if (XOUT == 0) {
          f32x4 o = {xv[rr][4 * i], xv[rr][4 * i + 1], xv[rr][4 * i + 2], xv[rr][4 * i + 3]};
          __builtin_nontemporal_store(o, (f32x4*)((float*)xout_ + ro + lane * 4 + 256 * i));
        } else {
          u32x2 o = {pack2(xv[rr][4 * i], xv[rr][4 * i + 1]), pack2(xv[rr][4 * i + 2], xv[rr][4 * i + 3])};
          *(u32x2*)((bf16_t*)xout_ + ro + lane * 4 + 256 * i) = o;
        }
      }
    }
    if (hout) {
#pragma unroll
      for (int o = 32; o >= 1; o >>= 1) { s2[0] += __shfl_xor(s2[0], o); s2[1] += __shfl_xor(s2[1], o); }
#pragma unroll
      for (int rr = 0; rr < 2; ++rr) {
        const float r2 = rsqrtf(s2[rr] * (1.f / 1024.f) + EPS);
#pragma unroll
        for (int i = 0; i < 4; ++i) {
          f32x4 gg = *(const f32x4*)(gnext + lane * 4 + 256 * i);
          u32x2 o; o[0] = pack2(xv[rr][4 * i] * r2 * gg[0], xv[rr][4 * i + 1] * r2 * gg[1]); o[1] = pack2(xv[rr][4 * i + 2] * r2 * gg[2], xv[rr][4 * i + 3] * r2 * gg[3]);
          *(u32x2*)(hout + (size_t)(row0 + rr) * 1024 + lane * 4 + 256 * i) = o;
        }
      }
    }
  }
}

DI void phase_gemm_plain(const bf16_t* A, int lda, const bf16_t* Wt, int K, int N, bf16_t* C, int ldc, char* smem) {
  const int NT = (N + 127) >> 7, MT = T / 128;
  for (int t = vbid(); t < MT * NT; t += vgrid()) {
    const int mt = t / NT, nt = t - mt * NT;
    LoadRows al{A, lda, mt * 128, T};
    LoadRows bl{Wt, K, nt * 128, N};
    EpStore ep{C, ldc, mt * 128, nt * 128, N};
    gemm_tile(al, bl, ep, K, smem);
  }
}

struct EpStore256 {
  static constexpr bool kBf16 = true;
  bf16_t* dst; int ld; int m0; int n0; int N;
  DI void operator()(const bf16_t* sCb) const {
    for (int id = tid512(); id < 8192; id += 512) {
      int row = id >> 5, c8 = (id & 31) * 8, n = n0 + c8;
      if (n < N) *(u32x4*)(dst + (size_t)(m0 + row) * ld + n) = *(const u32x4*)(sCb + row * BLD + c8);
    }
  }
};
DI void phase_gemm_plain256(const Sched& sc, const bf16_t* A, int lda, const bf16_t* Wt, int K, int N, bf16_t* C, int ldc, char* smem) {
  const int NT = (N + 255) >> 8, MT = T / 256;
  for (int round = 0;; ++round) {
    int mt = 0, nt = 0;
    const int st = sched_tile(sc, round, MT, NT, mt, nt);
    if (st == 2) break;
    if (st == 1) continue;
    LoadRows al{A, lda, mt * 256, T};
    LoadRows bl{Wt, K, nt * 256, N};
    EpStore256 ep{C, ldc, mt * 256, nt * 256, N};
    gemm_tile256(al, bl, ep, K, smem);
  }
}

DI void row_rs(const bf16_t* base, int ld, int m0, int ncols, float* srs) {
  const int tid = tidx(), row = tid >> 1, half = tid & 1;
  const bf16_t* pr = base + (size_t)(m0 + row) * ld + half * (ncols >> 1);
  float ss = 0.f;
  for (int c = 0; c < (ncols >> 1); c += 8) {
    u32x4 u = ldg16(pr + c);
#pragma unroll
    for (int q = 0; q < 4; ++q) { float a = bflo(u[q]), b = bfhi(u[q]); ss += a * a + b * b; }
  }
  ss += __shfl_xor(ss, 1);
  if (half == 0) srs[row] = rsqrtf(ss / (float)ncols + EPS);
}

struct EpQup {
  const Params* p; int m0; int n0;
  DI void operator()(float* sC) const {
    float* srs = sC + 128 * CLD;
    const bf16_t* P = (const bf16_t*)(p->ws + OFF_P);
    row_rs(P, 1952, m0, 256, srs);
    __syncthreads();
    const float2* rope = (const float2*)(p->ws + OFF_ROPEA);
    bf16_t* Qm = (bf16_t*)(p->ws + OFF_QM);
    const float qs = 0.10206207261596575f * LOG2E;
    for (int id = tidx(); id < 2048; id += 256) {
      int row = id >> 4, c8 = (id & 15) * 8, n = n0 + c8;
      float v[8]; ld8f(sC + row * CLD + c8, v);
      int d = n % 96;
      if (d >= 64) {
        int pos = (m0 + row) & 4095;
        bool first = (d - 64) < 16;
        int i0 = (d - 64) & 15;
        float pv[8]; ld8f(sC + row * CLD + c8 + (first ? 16 : -16), pv);
#pragma unroll
        for (int j = 0; j < 8; ++j) {
          float2 cs = rope[pos * 16 + i0 + j];
          v[j] = first ? (v[j] * cs.x - pv[j] * cs.y) : (v[j] * cs.x + pv[j] * cs.y);
        }
      }
      float sc = srs[row] * qs;
#pragma unroll
      for (int j = 0; j < 8; ++j) v[j] *= sc;
      store8(Qm + (size_t)(m0 + row) * 768 + n, v);
    }
  }
};

struct EpKVup {
  const Params* p; int m0; int nt;
  DI void operator()(float* sC) const {
    float* srs = sC + 128 * CLD;
    const bf16_t* P = (const bf16_t*)(p->ws + OFF_P);
    row_rs(P + 256, 1952, m0, 128, srs);
    __syncthreads();
    bf16_t* Kf = (bf16_t*)(p->ws + OFF_KF);
    bf16_t* Vt = (bf16_t*)(p->ws + OFF_VTM);
    const int hh = nt;
    for (int id = tidx(); id < 1024; id += 256) {
      int row = id >> 3, c8 = (id & 7) * 8;
      float v[8]; ld8f(sC + row * CLD + c8, v);
      float sc = srs[row];
#pragma unroll
      for (int j = 0; j < 8; ++j) v[j] *= sc;
      store8(Kf + (size_t)(m0 + row) * 768 + hh * 96 + c8, v);
    }
    const int b = m0 >> 12, s0 = m0 & 4095;
    for (int id = tidx(); id < 1024; id += 256) {
      int col = id & 63, rch = id >> 6;
      float v[8];
#pragma unroll
      for (int j = 0; j < 8; ++j) v[j] = sC[(rch * 8 + j) * CLD + 64 + col] * srs[rch * 8 + j];
      store8(Vt + ((size_t)(b * 8 + hh) * 64 + col) * 4096 + s0 + rch * 8, v);
    }
    if (nt == 0) {
      const float2* rope = (const float2*)(p->ws + OFF_ROPEA);
      for (int id = tidx(); id < 512; id += 256) {
        int row = id >> 2, c4 = id & 3;
        int pos = (m0 + row) & 4095;
        u32x4 u = ldg16(P + (size_t)(m0 + row) * 1952 + 384 + c4 * 8);
        u32x4 q = ldg16(P + (size_t)(m0 + row) * 1952 + 384 + (c4 ^ 2) * 8);
        bool first = c4 < 2;
        int i0 = (c4 & 1) * 8;
        float v[8];
#pragma unroll
        for (int j = 0; j < 8; ++j) {
          float a = (j & 1) ? bfhi(u[j >> 1]) : bflo(u[j >> 1]);
          float o = (j & 1) ? bfhi(q[j >> 1]) : bflo(q[j >> 1]);
          float2 cs = rope[pos * 16 + i0 + j];
          v[j] = first ? (a * cs.x - o * cs.y) : (a * cs.x + o * cs.y);
        }
#pragma unroll
        for (int h8 = 0; h8 < 8; ++h8) store8(Kf + (size_t)(m0 + row) * 768 + h8 * 96 + 64 + c4 * 8, v);
      }
    }
  }
};

DI void transpose_bf16_64(const bf16_t* __restrict__ src, int lds_, bf16_t* __restrict__ dst, int ldd, char* smem) {
  bf16_t* sT = (bf16_t*)smem;
  const int tid = tidx();
  __syncthreads();
#pragma unroll
  for (int i = 0; i < 2; ++i) {
    int row = (tid >> 3) + 32 * i, ck = tid & 7;
    u32x4 u = ldg16(src + (size_t)row * lds_ + ck * 8);
#pragma unroll
    for (int j = 0; j < 8; ++j) { unsigned wv = u[j >> 1]; sT[(ck * 8 + j) * 72 + row] = (bf16_t)((j & 1) ? (wv >> 16) : (wv & 0xffffu)); }
  }
  __syncthreads();
#pragma unroll
  for (int i = 0; i < 2; ++i) {
    int row = (tid >> 3) + 32 * i, ck = tid & 7;
    *(u32x4*)(dst + (size_t)row * ldd + ck * 8) = *(const u32x4*)(sT + row * 72 + ck * 8);
  }
}

constexpr int P2_QUP = 256 * 6, P2_KVUP = 256 * 8, P2_VT = 512 * 8;
DI void phase2(const Params& p, char* smem) {
  const bf16_t* P = (const bf16_t*)(p.ws + OFF_P);
  for (int it = vbid(); it < P2_QUP + P2_KVUP + P2_VT; it += vgrid()) {
    if (it < P2_QUP) {
      int mt = it / 6, nt = it - mt * 6;
      LoadRows al{P, 1952, mt * 128, T};
      LoadRows bl{(const bf16_t*)(p.ws + OFF_WT_QUP), 256, nt * 128, 768};
      EpQup ep{&p, mt * 128, nt * 128};
      gemm_tile(al, bl, ep, 256, smem);
    } else if (it < P2_QUP + P2_KVUP) {
      int j = it - P2_QUP; int mt = j >> 3, nt = j & 7;
      LoadRows al{P + 256, 1952, mt * 128, T};
      LoadRows bl{(const bf16_t*)(p.ws + OFF_WT_KVUP), 128, nt * 128, 1024};
      EpKVup ep{&p, mt * 128, nt};
      gemm_tile(al, bl, ep, 128, smem);
    } else {
      int j = it - P2_QUP - P2_KVUP; int tt = j >> 3, hh = j & 7;
      int b = tt >> 6, s0 = (tt & 63) * 64;
      transpose_bf16_64(P + (size_t)(tt * 64) * 1952 + 1440 + hh * 64, 1952,
                        (bf16_t*)(p.ws + OFF_VTN) + ((size_t)(b * 8 + hh) * 64) * 4096 + s0, 4096, smem);
    }
  }
}

template <int DQK, bool NA>
DI void attn_unit(const bf16_t* __restrict__ Qb, int ldq, const bf16_t* __restrict__ Kb, int ldk, const bf16_t* __restrict__ Vt,
                  bf16_t* __restrict__ Ob, int ldo, int u, float sc, const float* __restrict__ rpb_h, char* smem) {
  constexpr int KS = DQK + 8;
  constexpr int NKC = DQK / 8;
  constexpr int KCH = 64 * NKC;
  constexpr int NDS = DQK / 16;
  bf16_t* sK = (bf16_t*)smem;
  bf16_t* sV = sK + 2 * 64 * KS;
  float* sBias = (float*)(sV + 2 * 64 * 72);
  const int tid = tid512(), lane = tid & 63, w = tid >> 6, r = lane & 31, h = lane >> 5;
  int t_lo = 0, t_hi = 63;
  int rq = 0, rs = 0, cq = 0, cs = 0;
  if (NA) {
    int r0 = 4 * u;
    t_lo = clampi(r0 - 4, 0, 56);
    t_hi = clampi(r0 + 3 - 4, 0, 56) + 7;
    rq = r0 + (w >> 1); rs = clampi(rq - 4, 0, 56);
    cq = 32 * (w & 1) + r; cs = clampi(cq - 8, 0, 48);
  }
  __syncthreads();
  if (NA) { for (int i = tid; i < 15 * 31; i += 512) sBias[i] = rpb_h[i] * LOG2E; }
  u32x4 qf[NDS];
  {
    const bf16_t* qp = Qb + (size_t)(256 * u + 32 * w + r) * ldq + 8 * h;
#pragma unroll
    for (int ds = 0; ds < NDS; ++ds) qf[ds] = ldg16(qp + 16 * ds);
  }
  u32x4 kreg[2], vreg;
  const bool k2 = (tid + 512) < KCH;
  const int krow0 = tid / NKC, kck0 = tid - krow0 * NKC;
  const int krow1 = (tid + 512) / NKC, kck1 = (tid + 512) - krow1 * NKC;
  const int vrow = tid >> 3, vck = tid & 7;
  auto load_tile = [&](int kt) {
    kreg[0] = ldg16(Kb + (size_t)(64 * kt + krow0) * ldk + kck0 * 8);
    if (k2) kreg[1] = ldg16(Kb + (size_t)(64 * kt + krow1) * ldk + kck1 * 8);
    vreg = ldg16(Vt + (size_t)vrow * 4096 + 64 * kt + vck * 8);
  };
  auto store_tile = [&](int buf) {
    bf16_t* dK = sK + buf * 64 * KS; bf16_t* dV = sV + buf * 64 * 72;
    *(u32x4*)(dK + krow0 * KS + kck0 * 8) = kreg[0];
    if (k2) *(u32x4*)(dK + krow1 * KS + kck1 * 8) = kreg[1];
    const int g = vck >> 1, odd = vck & 1;
    u32x2 lo = {vreg[0], vreg[1]}, hi = {vreg[2], vreg[3]};
    *(u32x2*)(dV + vrow * 72 + g * 16 + (odd ? 4 : 0)) = lo;
    *(u32x2*)(dV + vrow * 72 + g * 16 + (odd ? 12 : 8)) = hi;
  };
  load_tile(t_lo);
  store_tile(0);
  __syncthreads();
  f32x16 o0, o1;
#pragma unroll
  for (int q = 0; q < 16; ++q) { o0[q] = 0.f; o1[q] = 0.f; }
  float m_run = -INFINITY, l_run = 0.f;
  for (int kt = t_lo; kt <= t_hi; ++kt) {
    const int cur = (kt - t_lo) & 1;
    const bool more = kt < t_hi;
    if (more) load_tile(kt + 1);
    bool active = true;
    if (NA) active = (kt >= rs) && (kt < rs + 8);
    if (active) {
      const bf16_t* cK = sK + cur * 64 * KS + r * KS + 8 * h;
      const bf16_t* cV = sV + cur * 64 * 72 + r * 72 + 8 * h;
      f32x16 s0, s1;
      {
        const f32x16 zero16 = {0.f, 0.f, 0.f, 0.f, 0.f, 0.f, 0.f, 0.f, 0.f, 0.f, 0.f, 0.f, 0.f, 0.f, 0.f, 0.f};
        u32x4 k0 = *(const u32x4*)(cK);
        u32x4 k1 = *(const u32x4*)(cK + 32 * KS);
        s0 = MFMA32(k0, qf[0], zero16);
        s1 = MFMA32(k1, qf[0], zero16);
      }
#pragma unroll
      for (int ds = 1; ds < NDS; ++ds) {
        u32x4 k0 = *(const u32x4*)(cK + ds * 16);
        u32x4 k1 = *(const u32x4*)(cK + 32 * KS + ds * 16);
        s0 = MFMA32(k0, qf[ds], s0);
        s1 = MFMA32(k1, qf[ds], s1);
      }
      if (NA) {
        const int brow = (kt - rq + 7) * 31;
#pragma unroll
        for (int q = 0; q < 16; ++q) {
          int kc0 = crow(q, h), kc1 = 32 + kc0;
          bool v0 = (kc0 >= cs) && (kc0 < cs + 16), v1 = (kc1 >= cs) && (kc1 < cs + 16);
          float b0 = v0 ? sBias[brow + kc0 - cq + 15] : 0.f;
          float b1 = v1 ? sBias[brow + kc1 - cq + 15] : 0.f;
          s0[q] = v0 ? (s0[q] * sc + b0) : -INFINITY;
          s1[q] = v1 ? (s1[q] * sc + b1) : -INFINITY;
        }
      }
      float mx = s0[0];
#pragma unroll
      for (int q = 1; q < 16; ++q) mx = fmaxf(mx, s0[q]);
#pragma unroll
      for (int q = 0; q < 16; ++q) mx = fmaxf(mx, s1[q]);
      mx = fmaxf(mx, __shfl_xor(mx, 32));
      if (__builtin_amdgcn_ballot_w64((mx - m_run) > 8.f) != 0ull) {
        const float m_new = fmaxf(m_run, mx);
        const float alpha = ex2(m_run - m_new);
        m_run = m_new;
        l_run *= alpha;
#pragma unroll
        for (int q = 0; q < 16; ++q) { o0[q] *= alpha; o1[q] *= alpha; }
      }
      const f2_t nm = {-m_run, -m_run};
      f2_t ls2 = {0.f, 0.f};
#pragma unroll
      for (int q = 0; q < 16; q += 2) {
        f2_t a = {s0[q], s0[q + 1]}, b = {s1[q], s1[q + 1]};
        a = a + nm; b = b + nm;
        a[0] = ex2(a[0]); a[1] = ex2(a[1]); b[0] = ex2(b[0]); b[1] = ex2(b[1]);
        s0[q] = a[0]; s0[q + 1] = a[1]; s1[q] = b[0]; s1[q + 1] = b[1];
        ls2 = ls2 + a; ls2 = ls2 + b;
      }
      l_run += ls2[0] + ls2[1];
      u32x4 pf[4];
#pragma unroll
      for (int s = 0; s < 2; ++s) {
        pf[s][0] = pack2(s0[8 * s], s0[8 * s + 1]); pf[s][1] = pack2(s0[8 * s + 2], s0[8 * s + 3]);
        pf[s][2] = pack2(s0[8 * s + 4], s0[8 * s + 5]); pf[s][3] = pack2(s0[8 * s + 6], s0[8 * s + 7]);
        pf[2 + s][0] = pack2(s1[8 * s], s1[8 * s + 1]); pf[2 + s][1] = pack2(s1[8 * s + 2], s1[8 * s + 3]);
        pf[2 + s][2] = pack2(s1[8 * s + 4], s1[8 * s + 5]); pf[2 + s][3] = pack2(s1[8 * s + 6], s1[8 * s + 7]);
      }
#pragma unroll
      for (int ks = 0; ks < 4; ++ks) {
        u32x4 v0 = *(const u32x4*)(cV + ks * 16);
        u32x4 v1 = *(const u32x4*)(cV + 32 * 72 + ks * 16);
        o0 = MFMA32(v0, pf[ks], o0);
        o1 = MFMA32(v1, pf[ks], o1);
      }
    }
    if (more) store_tile(cur ^ 1);
    __syncthreads();
  }
  l_run += __shfl_xor(l_run, 32);
  const float inv = 1.f / l_run;
  bf16_t* op = Ob + (size_t)(256 * u + 32 * w + r) * ldo;
#pragma unroll
  for (int g = 0; g < 4; ++g) {
    u32x2 a = {pack2(o0[4 * g] * inv, o0[4 * g + 1] * inv), pack2(o0[4 * g + 2] * inv, o0[4 * g + 3] * inv)};
    u32x2 b = {pack2(o1[4 * g] * inv, o1[4 * g + 1] * inv), pack2(o1[4 * g + 2] * inv, o1[4 * g + 3] * inv)};
    *(u32x2*)(op + 8 * g + 4 * h) = a;
    *(u32x2*)(op + 32 + 8 * g + 4 * h) = b;
  }
}

DI void phase3(const Sched& sc, const Params& p, char* smem) {
  bf16_t* AB = (bf16_t*)(p.ws + OFF_AB);
  int P = sc.minloc / 16; P = P < 1 ? 1 : P;
  const bool act = sc.rank < P * 16;
  const int u = sc.rank & 15;
  for (int kind = 0; kind < 2; ++kind) {
    for (int round = 0;; ++round) {
      const int pair0 = (round * sc.nx + sc.xs) * P;
      if (pair0 >= 64) break;
      const int pair = pair0 + (sc.rank >> 4);
      if (!act || pair >= 64) continue;
      const int hh = pair & 7, b = pair >> 3;
      if (kind == 0) {
        attn_unit<96, false>((const bf16_t*)(p.ws + OFF_QM) + (size_t)b * 4096 * 768 + hh * 96, 768,
                             (const bf16_t*)(p.ws + OFF_KF) + (size_t)b * 4096 * 768 + hh * 96, 768,
                             (const bf16_t*)(p.ws + OFF_VTM) + (size_t)(b * 8 + hh) * 64 * 4096,
                             AB + (size_t)b * 4096 * 1024 + hh * 64, 1024, u, 1.f, nullptr, smem);
      } else {
        const bf16_t* Pm = (const bf16_t*)(p.ws + OFF_P) + (size_t)b * 4096 * 1952;
        attn_unit<64, true>(Pm + 416 + hh * 64, 1952, Pm + 928 + hh * 64, 1952,
                            (const bf16_t*)(p.ws + OFF_VTN) + (size_t)(b * 8 + hh) * 64 * 4096,
                            AB + (size_t)b * 4096 * 1024 + 512 + hh * 64, 1024, u, 0.125f * LOG2E, p.a_rpb + hh * 15 * 31, smem);
      }
    }
  }
}

struct LoadFfnA {
  const bf16_t* H; int b; int p0;
  DI u32x4 operator()(int r, int k) const {
    int pos = clampi(p0 + r, 0, 4095);
    return ldg16(H + ((size_t)b * 4096 + pos) * 1024 + k);
  }
};
struct EpFfnUp {
  const float* conv; bf16_t* hid; int b; int p0; int c0;
  DI void operator()(const float* sC) const {
    for (int id = tidx(); id < 126 * 8; id += 256) {
      int rr = id >> 3, c8 = (id & 7) * 8, row = rr + 1, pos = p0 + row;
      if (pos < 4096) {
        float gm[8], g0[8], gp[8], uu[8], w0[8], w1[8], w2[8], v[8];
        ld8f(sC + (row - 1) * CLD + c8, gm); ld8f(sC + row * CLD + c8, g0); ld8f(sC + (row + 1) * CLD + c8, gp); ld8f(sC + row * CLD + 64 + c8, uu);
        if (pos == 0) { _Pragma("unroll") for (int j = 0; j < 8; ++j) gm[j] = 0.f; }
        if (pos == 4095) { _Pragma("unroll") for (int j = 0; j < 8; ++j) gp[j] = 0.f; }
        ld8f(conv + c0 + c8, w0); ld8f(conv + DFF + c0 + c8, w1); ld8f(conv + 2 * DFF + c0 + c8, w2);
#pragma unroll
        for (int j = 0; j < 8; ++j) {
          float g = w0[j] * gm[j] + w1[j] * g0[j] + w2[j] * gp[j];
          float y = 0.7978845608028654f * (g + 0.044715f * g * g * g);
          float e = __expf(-2.f * y);
          v[j] = g * __builtin_amdgcn_rcpf(1.f + e) * uu[j];
        }
        store8(hid + ((size_t)b * 4096 + pos) * DFF + c0 + c8, v);
      }
    }
  }
};
DI void phase_ffn_up(const Params& p, int layer, char* smem) {
  const bf16_t* H = (const bf16_t*)(p.hbuf);
  const bf16_t* Wt = (const bf16_t*)(p.ws + (layer ? OFF_WT_GU1 : OFF_WT_GU0));
  for (int t = vbid(); t < 264 * 44; t += vgrid()) {
    int mt = t / 44, nt = t - mt * 44, b = mt / 33, j = mt - b * 33;
    LoadFfnA al{H, b, 126 * j - 1};
    LoadRows bl{Wt, 1024, nt * 128, 5632};
    EpFfnUp ep{p.ffn_conv + (size_t)layer * 3 * DFF, (bf16_t*)(p.ws + OFF_HID), b, 126 * j - 1, nt * 64};
    gemm_tile(al, bl, ep, 1024, smem);
  }
}

constexpr size_t OFF_HG = OFF_M;
constexpr size_t OFF_HU = OFF_M + (size_t)128 * 4 * DFF * 2;
DI float gelu_gate(float g, float u) {
  float y = g * (-2.3022081985f - 0.1029432396f * g * g);
  return g * __builtin_amdgcn_rcpf(1.f + ex2(y)) * u;
}
struct EpFfnUp256 {
  static constexpr bool kBf16 = true;
  const float* conv; bf16_t* hid; bf16_t* hg; bf16_t* hu; int mt; int c0;
  DI void operator()(const bf16_t* sCb) const {
    const int t = tid512(), hf = (t >> 3) & 1, c8 = (t & 7) * 8;
    const int cb = c0 + 64 * hf;
    const bf16_t* base = sCb + 128 * hf;
    float w0[8], w1[8], w2[8];
    ld8f(conv + cb + c8, w0); ld8f(conv + DFF + cb + c8, w1); ld8f(conv + 2 * DFF + cb + c8, w2);
    for (int rr = t >> 4; rr < 254; rr += 32) {
      const int row = rr + 1;
      float gm[8], g0[8], gp[8], uu[8], v[8];
      ld8b(base + (row - 1) * BLD + c8, gm); ld8b(base + row * BLD + c8, g0); ld8b(base + (row + 1) * BLD + c8, gp); ld8b(base + row * BLD + 64 + c8, uu);
#pragma unroll
      for (int j = 0; j < 8; ++j) v[j] = gelu_gate(w0[j] * gm[j] + w1[j] * g0[j] + w2[j] * gp[j], uu[j]);
      store8(hid + ((size_t)mt * 256 + row) * DFF + cb + c8, v);
    }
    if (t < 16 * 6) {
      const int which = t >> 4;
      const int row = which < 4 ? ((which & 1) + 254 * (which >> 1)) : (which == 4 ? 0 : 255);
      const u32x4 val = *(const u32x4*)(base + row * BLD + (which < 4 ? 0 : 64) + c8);
      bf16_t* dst = which < 4 ? hg + ((size_t)mt * 4 + which) * DFF : hu + ((size_t)mt * 2 + (which - 4)) * DFF;
      *(u32x4*)(dst + cb + c8) = val;
    }
  }
};
DI void ffn_fixup(const Params& p, int layer) {
  const float* conv = p.ffn_conv + (size_t)layer * 3 * DFF;
  const bf16_t* hg = (const bf16_t*)(p.ws + OFF_HG);
  const bf16_t* hu = (const bf16_t*)(p.ws + OFF_HU);
  bf16_t* hid = (bf16_t*)(p.ws + OFF_HID);
  for (int id = (int)blockIdx.x * 512 + tid512(); id < 128 * 2 * 352; id += (int)gridDim.x * 512) {
    const int c = (id % 352) * 8, e = (id / 352) & 1, mt = id / 704;
    float gm[8], g0[8], gp[8], uu[8], w0[8], w1[8], w2[8], v[8];
    ld8f(conv + c, w0); ld8f(conv + DFF + c, w1); ld8f(conv + 2 * DFF + c, w2);
    int row;
    if (e == 0) {
      row = 0;
      if ((mt & 15) != 0) ld8b(hg + ((size_t)(mt - 1) * 4 + 3) * DFF + c, gm); else { _Pragma("unroll") for (int j = 0; j < 8; ++j) gm[j] = 0.f; }
      ld8b(hg + ((size_t)mt * 4 + 0) * DFF + c, g0); ld8b(hg + ((size_t)mt * 4 + 1) * DFF + c, gp); ld8b(hu + ((size_t)mt * 2 + 0) * DFF + c, uu);
    } else {
      row = 255;
      ld8b(hg + ((size_t)mt * 4 + 2) * DFF + c, gm); ld8b(hg + ((size_t)mt * 4 + 3) * DFF + c, g0); ld8b(hu + ((size_t)mt * 2 + 1) * DFF + c, uu);
      if ((mt & 15) != 15) ld8b(hg + ((size_t)(mt + 1) * 4 + 0) * DFF + c, gp); else { _Pragma("unroll") for (int j = 0; j < 8; ++j) gp[j] = 0.f; }
    }
#pragma unroll
    for (int j = 0; j < 8; ++j) v[j] = gelu_gate(w0[j] * gm[j] + w1[j] * g0[j] + w2[j] * gp[j], uu[j]);
    store8(hid + ((size_t)mt * 256 + row) * DFF + c, v);
  }
}
DI void phase_ffn_up256(const Sched& sc, const Params& p, int layer, char* smem) {
  const bf16_t* H = (const bf16_t*)(p.hbuf);
  const bf16_t* Wt = (const bf16_t*)(p.ws + (layer ? OFF_WT_GU1 : OFF_WT_GU0));
  for (int round = 0;; ++round) {
    int mt = 0, nt = 0;
    const int st = sched_tile(sc, round, 128, 22, mt, nt);
    if (st == 2) break;
    if (st == 1) continue;
    LoadRows al{H, 1024, mt * 256, T};
    LoadRows bl{Wt, 1024, nt * 256, 5632};
    EpFfnUp256 ep{p.ffn_conv + (size_t)layer * 3 * DFF, (bf16_t*)(p.ws + OFF_HID), (bf16_t*)(p.ws + OFF_HG), (bf16_t*)(p.ws + OFF_HU), mt, nt * 128};
    gemm_tile256(al, bl, ep, 1024, smem);
  }
}

struct EpIn1 {
  const Params* p; int m0; int nt; float rscale;
  DI void operator()(float* sC) const {
    const int b = m0 >> 12, s0 = m0 & 4095;
    char* ws = p->ws;
    if (nt < 8) {
      const float2* rope = (const float2*)(ws + OFF_ROPER);
      const float sc = (nt >= 4) ? 0.08838834764831845f : 1.f;
      for (int id = tidx(); id < 128 * 64; id += 256) {
        int row = id >> 6, i = id & 63;
        float2 cs = rope[(size_t)(s0 + row) * 64 + i];
        float x1 = sC[row * CLD + i], x2 = sC[row * CLD + i + 64];
        sC[row * CLD + i] = (x1 * cs.x - x2 * cs.y) * sc;
        sC[row * CLD + i + 64] = (x1 * cs.y + x2 * cs.x) * sc;
      }
      __syncthreads();
    }
    bf16_t* nat = nullptr; int ldn = 512, coff = 0;
    if (nt < 4) { nat = (bf16_t*)(ws + OFF_RQ); coff = nt * 128; }
    else if (nt < 8) { nat = (bf16_t*)(ws + OFF_RK); coff = (nt - 4) * 128; }
    else if (nt < 12) { nat = nullptr; }
    else if (nt < 16) { nat = (bf16_t*)(ws + OFF_RG); coff = (nt - 12) * 128; }
    else { nat = (bf16_t*)(ws + OFF_HY); ldn = 1536; coff = (nt - 16) * 128; }
    if (nat) {
      for (int id = tidx(); id < 2048; id += 256) {
        int row = id >> 4, c8 = (id & 15) * 8;
        float v[8]; ld8f(sC + row * CLD + c8, v);
        store8(nat + (size_t)(m0 + row) * ldn + coff + c8, v);
      }
    }
    if (nt >= 4 && nt < 12) {
      bf16_t* tp = (bf16_t*)(ws + (nt < 8 ? OFF_RKT : OFF_RVT));
      int hh = (nt - 4) & 3;
      for (int id = tidx(); id < 128 * 16; id += 256) {
        int col = id & 127, rch = id >> 7;
        float v[8];
#pragma unroll
        for (int j = 0; j < 8; ++j) v[j] = sC[(rch * 8 + j) * CLD + col];
        store8(tp + ((size_t)(b * 4 + hh) * 128 + col) * 4096 + s0 + rch * 8, v);
      }
    }
  }
};
DI void phase_in1(const Params& p, char* smem) {
  const bf16_t* H = (const bf16_t*)(p.hbuf);
  const bf16_t* Wt = (const bf16_t*)(p.ws + OFF_WT_IN1);
  for (int t = vbid(); t < 256 * 28; t += vgrid()) {
    int mt = t / 28, nt = t - mt * 28;
    LoadRows al{H, 1024, mt * 128, T};
    LoadRows bl{Wt, 1024, nt * 128, 3584};
    EpIn1 ep{&p, mt * 128, nt, 1.f};
    gemm_tile(al, bl, ep, 1024, smem);
  }
}

struct EpIn1_256 {
  static constexpr bool kBf16 = true;
  const Params* p; int m0; int nt2;
  DI void operator()(bf16_t* sCb) const {
    const int b = m0 >> 12, s0 = m0 & 4095;
    char* ws = p->ws;
    if (nt2 < 4) {
      const float2* rope = (const float2*)(ws + OFF_ROPER);
      const float sc = (nt2 >= 2) ? 0.08838834764831845f : 1.f;
      for (int id = tid512(); id < 256 * 128; id += 512) {
        int row = id >> 7, hf = (id >> 6) & 1, i = id & 63;
        float2 cs = rope[(size_t)(s0 + row) * 64 + i];
        bf16_t* q1 = sCb + row * BLD + 128 * hf + i;
        float x1 = bf2f(q1[0]), x2 = bf2f(q1[64]);
        q1[0] = f2bf((x1 * cs.x - x2 * cs.y) * sc);
        q1[64] = f2bf((x1 * cs.y + x2 * cs.x) * sc);
      }
      __syncthreads();
    }
#pragma unroll 1
    for (int hf = 0; hf < 2; ++hf) {
      const int nt = 2 * nt2 + hf;
      const bf16_t* base = sCb + 128 * hf;
      bf16_t* nat = nullptr; int ldn = 512, coff = 0;
      if (nt < 4) { nat = (bf16_t*)(ws + OFF_RQ); coff = nt * 128; }
      else if (nt < 8) { nat = (bf16_t*)(ws + OFF_RK); coff = (nt - 4) * 128; }
      else if (nt < 12) { nat = nullptr; }
      else if (nt < 16) { nat = (bf16_t*)(ws + OFF_RG); coff = (nt - 12) * 128; }
      else { nat = (bf16_t*)(ws + OFF_HY); ldn = 1536; coff = (nt - 16) * 128; }
      if (nat) {
        for (int id = tid512(); id < 4096; id += 512) {
          int row = id >> 4, c8 = (id & 15) * 8;
          *(u32x4*)(nat + (size_t)(m0 + row) * ldn + coff + c8) = *(const u32x4*)(base + row * BLD + c8);
        }
      }
      if (nt >= 4 && nt < 12) {
        bf16_t* tp = (bf16_t*)(ws + (nt < 8 ? OFF_RKT : OFF_RVT));
        int hh = (nt - 4) & 3;
        for (int id = tid512(); id < 128 * 32; id += 512) {
          int col = id & 127, rch = id >> 7;
          unsigned short e[8];
#pragma unroll
          for (int j = 0; j < 8; ++j) e[j] = base[(rch * 8 + j) * BLD + col];
          u32x4 o = {(unsigned)e[0] | ((unsigned)e[1] << 16), (unsigned)e[2] | ((unsigned)e[3] << 16), (unsigned)e[4] | ((unsigned)e[5] << 16), (unsigned)e[6] | ((unsigned)e[7] << 16)};
          *(u32x4*)(tp + ((size_t)(b * 4 + hh) * 128 + col) * 4096 + s0 + rch * 8) = o;
        }
      }
    }
  }
};
DI void phase_in1_256(const Sched& sc, const Params& p, char* smem) {
  const bf16_t* H = (const bf16_t*)(p.hbuf);
  const bf16_t* Wt = (const bf16_t*)(p.ws + OFF_WT_IN1);
  for (int round = 0;; ++round) {
    int mt = 0, nt = 0;
    const int st = sched_tile(sc, round, 128, 14, mt, nt);
    if (st == 2) break;
    if (st == 1) continue;
    LoadRows al{H, 1024, mt * 256, T};
    LoadRows bl{Wt, 1024, nt * 256, 3584};
    EpIn1_256 ep{&p, mt * 256, nt};
    gemm_tile256(al, bl, ep, 1024, smem);
  }
}

DI float log_sigmoid(float x) { return fminf(x, 0.f) - log1pf(expf(-fabsf(x))); }

struct LoadKtScaled {
  const bf16_t* base; float l2g; int mode;
  DI u32x4 operator()(int r, int k) const {
    u32x4 u = ldg16(base + (size_t)r * 4096 + k);
    u32x4 o;
#pragma unroll
    for (int q = 0; q < 4; ++q) {
      int c = k + 2 * q;
      float e0 = mode ? (float)c : (float)(127 - c), e1 = mode ? (float)(c + 1) : (float)(126 - c);
      o[q] = pack2(bflo(u[q]) * ex2(e0 * l2g), bfhi(u[q]) * ex2(e1 * l2g));
    }
    return o;
  }
};
struct LoadStrided { const bf16_t* base; DI u32x4 operator()(int r, int k) const { return ldg16(base + (size_t)r * 4096 + k); } };

DI void hyena_pre_tile(const Params& p, int item, char* smem) {
  const int tid = tidx();
  const int ct = item & 7, st = (item >> 3) & 63, b = item >> 9;
  const bf16_t* HY = (const bf16_t*)(p.ws + OFF_HY) + (size_t)b * 4096 * 1536;
  bf16_t* sT = (bf16_t*)smem;
  __syncthreads();
#pragma unroll
  for (int i = 0; i < 2; ++i) {
    int row = (tid >> 3) + 32 * i, ck = tid & 7, s = st * 64 + row, c = ct * 64 + ck * 8;
    float x1[8], vv[8];
#pragma unroll
    for (int j = 0; j < 8; ++j) { x1[j] = 0.f; vv[j] = 0.f; }
#pragma unroll
    for (int d = -1; d <= 1; ++d) {
      int ss = s + d;
      if (ss >= 0 && ss < 4096) {
        u32x4 a = ldg16(HY + (size_t)ss * 1536 + 512 + c), bb = ldg16(HY + (size_t)ss * 1536 + 1024 + c);
        float wa[8], wb[8]; ld8f(p.c_short + (d + 1) * 1536 + 512 + c, wa); ld8f(p.c_short + (d + 1) * 1536 + 1024 + c, wb);
#pragma unroll
        for (int q = 0; q < 4; ++q) {
          x1[2 * q] += wa[2 * q] * bflo(a[q]); x1[2 * q + 1] += wa[2 * q + 1] * bfhi(a[q]);
          vv[2 * q] += wb[2 * q] * bflo(bb[q]); vv[2 * q + 1] += wb[2 * q + 1] * bfhi(bb[q]);
        }
      }
    }
#pragma unroll
    for (int j = 0; j < 8; ++j) sT[(ck * 8 + j) * 72 + row] = f2bf(x1[j] * vv[j]);
  }
  __syncthreads();
  bf16_t* uT = (bf16_t*)(p.hbuf + HB_UT);
#pragma unroll
  for (int i = 0; i < 2; ++i) {
    int row = (tid >> 3) + 32 * i, ck = tid & 7;
    *(u32x4*)(uT + ((size_t)(ct * 64 + row) * 8 + b) * 4096 + st * 64 + ck * 8) = *(const u32x4*)(sT + row * 72 + ck * 8);
  }
}

struct EpKV {
  bf16_t* dst;
  DI void operator()(const float* sC) const {
    for (int id = tidx(); id < 2048; id += 256) {
      int row = id >> 4, c8 = (id & 15) * 8;
      float v[8]; ld8f(sC + row * CLD + c8, v); store8(dst + row * 128 + c8, v);
    }
  }
};

constexpr int P10_KV = 2048, P10_HY = 4096;
DI void phase10(const Params& p, char* smem) {
  for (int it = vbid(); it < P10_KV + P10_HY; it += vgrid()) {
    if (it < P10_KV) {
      int dir = it & 1, unit = it >> 1;
      int n = unit & 31, bh = unit >> 5, hh = bh & 3;
      float lg = log_sigmoid(dir ? p.c_decay_b[hh] : p.c_decay_f[hh]) * LOG2E;
      LoadStrided al{(const bf16_t*)(p.ws + OFF_RVT) + (size_t)bh * 128 * 4096 + n * 128};
      LoadKtScaled bl{(const bf16_t*)(p.ws + OFF_RKT) + (size_t)bh * 128 * 4096 + n * 128, lg, dir};
      EpKV ep{(bf16_t*)(p.ws + (dir ? OFF_KVB : OFF_KVF)) + (size_t)unit * 16384};
      gemm_tile(al, bl, ep, 128, smem);
    } else {
      hyena_pre_tile(p, it - P10_KV, smem);
    }
  }
}

DI void retention_scan_item(const Params& p, int item) {
  const int per_dir = 32 * 8192 / 256;
  int dir = item / per_dir, j = item - dir * per_dir;
  int idx2 = j * 256 + tidx();
  int bh = idx2 >> 13, e2 = idx2 & 8191, hh = bh & 3;
  float lg = log_sigmoid(dir ? p.c_decay_b[hh] : p.c_decay_f[hh]) * LOG2E;
  float G = ex2(128.f * lg);
  unsigned* base = (unsigned*)(p.ws + (dir ? OFF_KVB : OFF_KVF)) + (size_t)bh * 32 * 8192 + e2;
  float s0 = 0.f, s1 = 0.f;
  if (!dir) {
    for (int n = 0; n < 32; ++n) {
      unsigned v = base[(size_t)n * 8192];
      base[(size_t)n * 8192] = pack2(s0, s1);
      s0 = G * s0 + bflo(v); s1 = G * s1 + bfhi(v);
    }
  } else {
    for (int n = 31; n >= 0; --n) {
      unsigned v = base[(size_t)n * 8192];
      base[(size_t)n * 8192] = pack2(s0, s1);
      s0 = G * s0 + bflo(v); s1 = G * s1 + bfhi(v);
    }
  }
}

DI void hyena_conv_unit(const Params& p, int item, char* smem) {
  const int tid = tidx(), lane = tid & 63, w = tid >> 6;
  const int c = item >> 1, bh2 = item & 1, b = bh2 * 4 + w;
  bf16_t* sG0 = (bf16_t*)smem;
  bf16_t* sG1 = sG0 + 8200;
  bf16_t* sU = sG1 + 8200;
  const bf16_t* G = (const bf16_t*)(p.ws + OFF_FILT) + (size_t)c * 8192;
  __syncthreads();
  for (int x = tid; x < 8192; x += 256) {
    bf16_t v = G[8191 - x];
    sG0[x] = v;
    if (x >= 1) sG1[x - 1] = v;
  }
  if (tid == 0) sG1[8191] = 0;
  {
    const bf16_t* ub = (const bf16_t*)(p.hbuf + HB_UT) + ((size_t)c * 8 + b) * 4096;
    bf16_t* su = sU + w * 64 * 72;
#pragma unroll
    for (int i = 0; i < 8; ++i) { int id = lane + 64 * i; int row = id >> 3, ck = id & 7; *(u32x4*)(su + row * 72 + ck * 8) = ldg16(ub + row * 64 + ck * 8); }
  }
  __syncthreads();
  const int n = lane & 15, g = lane >> 4;
  const bf16_t* su = sU + w * 64 * 72;
  f32x4 acc[4][4];
#pragma unroll
  for (int i = 0; i < 4; ++i)
#pragma unroll
    for (int j = 0; j < 4; ++j) { acc[i][j][0] = 0.f; acc[i][j][1] = 0.f; acc[i][j][2] = 0.f; acc[i][j][3] = 0.f; }
  auto bfrag = [&](int E) -> u32x4 {
    int a = 4095 - 16 * E - n + 8 * g;
    const bf16_t* src = (a & 1) ? (sG1 + (a - 1)) : (sG0 + a);
    const unsigned* s32 = (const unsigned*)src;
    u32x4 o = {s32[0], s32[1], s32[2], s32[3]};
    return o;
  };
  for (int d = -63; d <= 63; ++d) {
#pragma unroll
    for (int kk = 0; kk < 2; ++kk) {
      u32x4 bfr[4];
#pragma unroll
      for (int nn = 0; nn < 4; ++nn) bfr[nn] = bfrag(4 * d + nn - 2 * kk);
#pragma unroll
      for (int rb = 0; rb < 4; ++rb) {
        if (d >= 16 * rb - 63 && d <= 16 * rb + 15) {
          int t1 = 16 * rb + n, s1 = t1 - d;
          u32x4 a = zero4();
          if (s1 >= 0 && s1 < 64) a = *(const u32x4*)(su + s1 * 72 + 32 * kk + 8 * g);
#pragma unroll
          for (int nn = 0; nn < 4; ++nn) acc[rb][nn] = MFMA16(a, bfr[nn], acc[rb][nn]);
        }
      }
    }
  }
  bf16_t* yT = (bf16_t*)(p.hbuf + HB_YT) + ((size_t)c * 8 + b) * 4096;
#pragma unroll
  for (int rb = 0; rb < 4; ++rb)
#pragma unroll
    for (int nn = 0; nn < 4; ++nn)
#pragma unroll
      for (int q = 0; q < 4; ++q) yT[(16 * rb + 4 * g + q) * 64 + 16 * nn + n] = f2bf(acc[rb][nn][q]);
}

constexpr int P11_SCAN = 2 * (32 * 8192 / 256), P11_CONV = 1024;
DI void phase11(const Params& p, char* smem) {
  for (int it = vbid(); it < P11_CONV + P11_SCAN; it += vgrid()) {
    if (it < P11_CONV) hyena_conv_unit(p, it, smem);
    else retention_scan_item(p, it - P11_CONV);
  }
}

DI void stage_tile128(bf16_t* sT, const bf16_t* __restrict__ src, size_t ld, bool perm) {
  const int tid = tidx();
  __syncthreads();
#pragma unroll
  for (int hlf = 0; hlf < 2; ++hlf) {
    u32x4 regs[4];
#pragma unroll
    for (int i = 0; i < 4; ++i) { int id = tid + 256 * (4 * hlf + i); int row = id >> 4, ck = id & 15; regs[i] = ldg16(src + (size_t)row * ld + ck * 8); }
#pragma unroll
    for (int i = 0; i < 4; ++i) {
      int id = tid + 256 * (4 * hlf + i); int row = id >> 4, ck = id & 15;
      if (!perm) *(u32x4*)(sT + row * 136 + ck * 8) = regs[i];
      else {
        int g = ck >> 1, odd = ck & 1;
        u32x2 lo = {regs[i][0], regs[i][1]}, hi = {regs[i][2], regs[i][3]};
        *(u32x2*)(sT + row * 136 + g * 16 + (odd ? 4 : 0)) = lo;
        *(u32x2*)(sT + row * 136 + g * 16 + (odd ? 12 : 8)) = hi;
      }
    }
  }
  __syncthreads();
}

DI void load_qf8(const bf16_t* __restrict__ qp, u32x4* qf) {
#pragma unroll
  for (int ds = 0; ds < 8; ++ds) qf[ds] = ldg16(qp + 16 * ds);
}
DI void retention_out_unit(const Params& p, int unit, char* smem) {
  const int tid = tidx(), lane = tid & 63, w = tid >> 6, r = lane & 31, h = lane >> 5;
  const int n = unit & 31, bh = unit >> 5, hh = bh & 3, b = bh >> 2;
  const size_t tok0 = (size_t)b * 4096 + n * 128;
  bf16_t* sT = (bf16_t*)smem;
  const float lgf = log_sigmoid(p.c_decay_f[hh]) * LOG2E, lgb = log_sigmoid(p.c_decay_b[hh]) * LOG2E;
  const bf16_t* qp = (const bf16_t*)(p.ws + OFF_RQ) + (tok0 + 32 * w + r) * 512 + hh * 128 + 8 * h;
  int cq = 32 * w + r;
  asm volatile("" : "+v"(cq));
  stage_tile128(sT, (const bf16_t*)(p.ws + OFF_RK) + tok0 * 512 + hh * 128, 512, false);
  u32x4 pf[8];
  {
    u32x4 qf[8];
    load_qf8(qp, qf);
#pragma unroll
    for (int mb = 0; mb < 4; ++mb) {
      f32x16 s;
#pragma unroll
      for (int q = 0; q < 16; ++q) s[q] = 0.f;
      const bf16_t* cK = sT + (32 * mb + r) * 136 + 8 * h;
#pragma unroll
      for (int ds = 0; ds < 8; ++ds) { u32x4 k = *(const u32x4*)(cK + 16 * ds); s = MFMA32(k, qf[ds], s); }
#pragma unroll
      for (int q = 0; q < 16; ++q) {
        int m = 32 * mb + crow(q, h);
        int diff = cq - m;
        float dec = (diff >= 0) ? ex2((float)diff * lgf) : ex2((float)(-diff) * lgb);
        s[q] *= dec;
      }
#pragma unroll
      for (int sx = 0; sx < 2; ++sx) {
        pf[2 * mb + sx][0] = pack2(s[8 * sx], s[8 * sx + 1]); pf[2 * mb + sx][1] = pack2(s[8 * sx + 2], s[8 * sx + 3]);
        pf[2 * mb + sx][2] = pack2(s[8 * sx + 4], s[8 * sx + 5]); pf[2 * mb + sx][3] = pack2(s[8 * sx + 6], s[8 * sx + 7]);
      }
    }
  }
  stage_tile128(sT, (const bf16_t*)(p.ws + OFF_RVT) + (size_t)bh * 128 * 4096 + n * 128, 4096, true);
  f32x16 o[4];
#pragma unroll
  for (int eb = 0; eb < 4; ++eb) {
#pragma unroll
    for (int q = 0; q < 16; ++q) o[eb][q] = 0.f;
    const bf16_t* cV = sT + (32 * eb + r) * 136 + 8 * h;
#pragma unroll
    for (int ks = 0; ks < 8; ++ks) { u32x4 v = *(const u32x4*)(cV + 16 * ks); o[eb] = MFMA32(v, pf[ks], o[eb]); }
  }
#pragma unroll 1
  for (int dir = 0; dir < 2; ++dir) {
    stage_tile128(sT, (const bf16_t*)(p.ws + (dir ? OFF_KVB : OFF_KVF)) + (size_t)unit * 16384, 128, false);
    u32x4 qf[8];
    load_qf8(qp, qf);
    const float xi = dir ? ex2((float)(128 - cq) * lgb) : ex2((float)(cq + 1) * lgf);
#pragma unroll
    for (int eb = 0; eb < 4; ++eb) {
      f32x16 t;
#pragma unroll
      for (int q = 0; q < 16; ++q) t[q] = 0.f;
      const bf16_t* cS = sT + (32 * eb + r) * 136 + 8 * h;
#pragma unroll
      for (int ds = 0; ds < 8; ++ds) { u32x4 sv = *(const u32x4*)(cS + 16 * ds); t = MFMA32(sv, qf[ds], t); }
#pragma unroll
      for (int q = 0; q < 16; ++q) o[eb][q] += xi * t[q];
    }
  }
  float ss = 0.f;
#pragma unroll
  for (int eb = 0; eb < 4; ++eb)
#pragma unroll
    for (int q = 0; q < 16; ++q) ss += o[eb][q] * o[eb][q];
  ss += __shfl_xor(ss, 32);
  const float rn = rsqrtf(ss * (1.f / 128.f) + EPS);
  const bf16_t* gp = (const bf16_t*)(p.ws + OFF_RG) + (tok0 + cq) * 512 + hh * 128;
  bf16_t* op = (bf16_t*)(p.ws + OFF_AB) + (tok0 + cq) * 1024 + hh * 128;
#pragma unroll
  for (int eb = 0; eb < 4; ++eb)
#pragma unroll
    for (int g4 = 0; g4 < 4; ++g4) {
      int e = 32 * eb + 8 * g4 + 4 * h;
      u32x2 gu = *(const u32x2*)(gp + e);
      float gv[4] = {bflo(gu[0]), bfhi(gu[0]), bflo(gu[1]), bfhi(gu[1])};
      float ov[4];
#pragma unroll
      for (int q = 0; q < 4; ++q) { float gg = gv[q]; float sl = gg * __builtin_amdgcn_rcpf(1.f + __expf(-gg)); ov[q] = o[eb][4 * g4 + q] * rn * sl; }
      u32x2 st = {pack2(ov[0], ov[1]), pack2(ov[2], ov[3])};
      *(u32x2*)(op + e) = st;
    }
}

DI void hyena_post_tile(const Params& p, int item, char* smem) {
  const int tid = tidx();
  const int ct = item & 7, st = (item >> 3) & 63, b = item >> 9;
  const bf16_t* HY = (const bf16_t*)(p.ws + OFF_HY) + (size_t)b * 4096 * 1536;
  const bf16_t* yT = (const bf16_t*)(p.hbuf + HB_YT);
  bf16_t* sT = (bf16_t*)smem;
  __syncthreads();
#pragma unroll
  for (int i = 0; i < 2; ++i) {
    int row = (tid >> 3) + 32 * i, ck = tid & 7;
    u32x4 u = ldg16(yT + ((size_t)(ct * 64 + row) * 8 + b) * 4096 + st * 64 + ck * 8);
#pragma unroll
    for (int j = 0; j < 8; ++j) { unsigned wv = u[j >> 1]; sT[(ck * 8 + j) * 72 + row] = (bf16_t)((j & 1) ? (wv >> 16) : (wv & 0xffffu)); }
  }
  __syncthreads();
  bf16_t* CD = (bf16_t*)(p.ws + OFF_AB);
#pragma unroll
  for (int i = 0; i < 2; ++i) {
    int row = (tid >> 3) + 32 * i, ck = tid & 7, s = st * 64 + row, c = ct * 64 + ck * 8;
    float x0[8];
#pragma unroll
    for (int j = 0; j < 8; ++j) x0[j] = 0.f;
#pragma unroll
    for (int d = -1; d <= 1; ++d) {
      int ss = s + d;
      if (ss >= 0 && ss < 4096) {
        u32x4 a = ldg16(HY + (size_t)ss * 1536 + c);
        float wa[8]; ld8f(p.c_short + (d + 1) * 1536 + c, wa);
#pragma unroll
        for (int q = 0; q < 4; ++q) { x0[2 * q] += wa[2 * q] * bflo(a[q]); x0[2 * q + 1] += wa[2 * q + 1] * bfhi(a[q]); }
      }
    }
    u32x4 y = *(const u32x4*)(sT + row * 72 + ck * 8);
    float v[8];
#pragma unroll
    for (int q = 0; q < 4; ++q) { v[2 * q] = bflo(y[q]) * x0[2 * q]; v[2 * q + 1] = bfhi(y[q]) * x0[2 * q + 1]; }
    store8(CD + ((size_t)b * 4096 + s) * 1024 + 512 + c, v);
  }
}

constexpr int P12_RET = 1024, P12_HY = 4096;
DI void phase12(const Params& p, char* smem) {
  for (int it = vbid(); it < P12_RET + P12_HY; it += vgrid()) {
    if (it < P12_RET) retention_out_unit(p, it, smem);
    else hyena_post_tile(p, it - P12_RET, smem);
  }
}

constexpr int NPHASE = 18;
DI void run_phase(const Sched& sc, const Params& p, int ph, char* smem_full) {
  char* ws = p.ws;
  char* smem = smem_full + vhalf() * SMEM_HALF;
  bf16_t* H = (bf16_t*)(p.hbuf);
  bf16_t* XB = (bf16_t*)(ws + OFF_H);
  bf16_t* AB = (bf16_t*)(ws + OFF_AB);
  bf16_t* M = (bf16_t*)(ws + OFF_M);
  bf16_t* HID = (bf16_t*)(ws + OFF_HID);
  switch (ph) {
    case 0: phase0(p, smem); break;
    case 1: phase_gemm_plain256(sc, H, 1024, (const bf16_t*)(ws + OFF_WT_IN0), 1024, 1952, (bf16_t*)(ws + OFF_P), 1952, smem_full); break;
    case 2: phase2(p, smem); break;
    case 3: phase3(sc, p, smem_full); break;
    case 4: phase_gemm_plain256(sc, AB, 1024, (const bf16_t*)(ws + OFF_WT_OUT0), 1024, 1024, M, 1024, smem_full); break;
    case 5: phase_resid<0, 1>(p.x, XB, M, p.mix_post, p.ffn_pre, H); break;
    case 6: phase_ffn_up256(sc, p, 0, smem_full); break;
    case 7: phase_gemm_plain256(sc, HID, DFF, (const bf16_t*)(ws + OFF_WT_DN0), DFF, 1024, M, 1024, smem_full); break;
    case 8: phase_resid<1, 1>(XB, XB, M, p.ffn_post, p.mix_pre + 1024, H); break;
    case 9: phase_in1_256(sc, p, smem_full); break;
    case 10: phase10(p, smem); break;
    case 11: phase11(p, smem); break;
    case 12: phase12(p, smem); break;
    case 13: phase_gemm_plain256(sc, AB, 1024, (const bf16_t*)(ws + OFF_WT_OUT1), 1024, 1024, M, 1024, smem_full); break;
    case 14: phase_resid<1, 1>(XB, XB, M, p.mix_post + 1024, p.ffn_pre + 1024, H); break;
    case 15: phase_ffn_up256(sc, p, 1, smem_full); break;
    case 16: phase_gemm_plain256(sc, HID, DFF, (const bf16_t*)(ws + OFF_WT_DN1), DFF, 1024, M, 1024, smem_full); break;
    case 17: phase_resid<1, 0>(XB, p.out, M, p.ffn_post + 1024, nullptr, nullptr); break;
    default: break;
  }
}

#if MEGA
#define BW(i) ((i) * 64)
DI unsigned ba_ld(unsigned* p) { return __hip_atomic_load(p, __ATOMIC_RELAXED, __HIP_MEMORY_SCOPE_AGENT); }
DI unsigned ba_add(unsigned* p, unsigned v) { return __hip_atomic_fetch_add(p, v, __ATOMIC_RELAXED, __HIP_MEMORY_SCOPE_AGENT); }
struct GridBar { unsigned* bar; unsigned x, nloc, nx, k; };
DI void gbar_spin(unsigned* p, unsigned target, unsigned* tmo) {
  unsigned sp = 0;
  while (ba_ld(p) < target) {
    __builtin_amdgcn_s_sleep(1);
    if ((++sp & 1023u) == 0u) { if (ba_ld(tmo)) break; if (sp > (1u << 23)) { ba_add(tmo, 1u); break; } }
  }
}
DI void gbar(GridBar& b) {
  asm volatile("s_waitcnt vmcnt(0)" ::: "memory");
  __syncthreads();
  b.k++;
  if (tid512() == 0) {
    unsigned* bar = b.bar;
    unsigned old = ba_add(&bar[BW(16 + b.x)], 1u);
    if (old + 1u == b.k * b.nloc) {
      __builtin_amdgcn_fence(__ATOMIC_RELEASE, "agent");
      asm volatile("s_waitcnt vmcnt(0)" ::: "memory");
      ba_add(&bar[BW(48)], 1u);
      gbar_spin(&bar[BW(48)], b.k * b.nx, &bar[BW(49)]);
      __hip_atomic_store(&bar[BW(32 + b.x)], b.k, __ATOMIC_RELAXED, __HIP_MEMORY_SCOPE_AGENT);
    } else {
      gbar_spin(&bar[BW(32 + b.x)], b.k, &bar[BW(49)]);
    }
    __builtin_amdgcn_fence(__ATOMIC_ACQUIRE, "agent");
    asm volatile("s_waitcnt vmcnt(0)" ::: "memory");
  }
  __syncthreads();
}
template <int PH>
DI void mega_phases(const Sched& sc, const Params& p, char* smem, GridBar& gb) {
  if constexpr (PH == 7 || PH == 16) { ffn_fixup(p, PH == 16 ? 1 : 0); gbar(gb); }
  run_phase(sc, p, PH, smem);
  if constexpr (((DUP_MASK >> PH) & 1) != 0) { gbar(gb); run_phase(sc, p, PH, smem); }
  if constexpr (PH + 1 < NPHASE) { gbar(gb); if (DUP_SYNC) gbar(gb); mega_phases<PH + 1>(sc, p, smem, gb); }
}
__global__ void __launch_bounds__(512, 2) k_mega(Params p) {
  __shared__ __attribute__((aligned(16))) char smem[SMEM_TOTAL];
  cg::grid_group grid = cg::this_grid();
  GridBar gb;
  gb.bar = (unsigned*)(p.ws + OFF_BAR);
  gb.x = (unsigned)__builtin_amdgcn_s_getreg((3 << 11) | 20) & 0xFu;
  gb.k = 0;
  __shared__ int s_rank;
  if (tid512() == 0) s_rank = (int)ba_add(&gb.bar[BW(gb.x)], 1u);
  Sched sc{0, 1, 0, 1};
  run_phase(sc, p, 0, smem);
  grid.sync();
  {
    unsigned nx = 0, xs = 0, minloc = 0xffffffffu;
    for (int j = 0; j < 16; ++j) {
      unsigned c = ba_ld(&gb.bar[BW(j)]);
      if (c != 0u) { nx++; if ((unsigned)j < gb.x) xs++; minloc = c < minloc ? c : minloc; }
    }
    gb.nx = nx; gb.nloc = ba_ld(&gb.bar[BW(gb.x)]);
    sc.xs = (int)xs; sc.nx = (int)nx; sc.minloc = (int)minloc; sc.rank = __builtin_amdgcn_readfirstlane(s_rank);
  }
  mega_phases<1>(sc, p, smem, gb);
}
#endif

template <int PH>
__global__ void __launch_bounds__(512, 2) k_phase(Params p) {
  __shared__ __attribute__((aligned(16))) char smem[SMEM_TOTAL];
  Sched sc{(int)(blockIdx.x & 7), 8, (int)(blockIdx.x >> 3), (int)(gridDim.x >> 3)};
  if constexpr (PH == 7 || PH == 16) { ffn_fixup(p, PH == 16 ? 1 : 0); __threadfence(); }
  run_phase(sc, p, PH, smem);
}
template <int PH>
static void launch_phases(const Params& p, hipStream_t stream) {
  hipLaunchKernelGGL(k_phase<PH>, dim3(256), dim3(512), 0, stream, p);
  if constexpr (PH + 1 < NPHASE) launch_phases<PH + 1>(p, stream);
}

extern "C" void kernel_launch(void* const* d_in, const int* in_sizes, int n_in, void* d_out, int out_size, void* d_ws, size_t ws_size,
                              hipStream_t stream) {
  Params p{};
  const float** f = (const float**)&p;
  for (int i = 0; i < 30; ++i) f[i] = (const float*)d_in[i];
  p.out = (float*)d_out;
  p.ws = (char*)d_ws;
  p.hbuf = (char*)d_out + (size_t)T * 1024 * 2;
#if MEGA
  static int grid_blocks = 0;
  if (!grid_blocks) {
    int dev = 0, cus = 0, per_cu = 0;
    hipGetDevice(&dev);
    hipDeviceGetAttribute(&cus, hipDeviceAttributeMultiprocessorCount, dev);
    hipOccupancyMaxActiveBlocksPerMultiprocessor(&per_cu, k_mega, 512, 0);
    if (per_cu > 1) per_cu = 1;
    grid_blocks = cus * per_cu;
  }
  hipMemsetAsync((char*)d_ws + OFF_BAR, 0, BAR_BYTES, stream);
  void* args[] = {&p};
  hipError_t e = hipLaunchCooperativeKernel((void*)k_mega, dim3(grid_blocks), dim3(512), args, 0, stream);
  if (e != hipSuccess) fprintf(stderr, "cooperative launch failed: %s (grid %d)\n", hipGetErrorString(e), grid_blocks);
#else
  launch_phases<0>(p, stream);
#endif
}
```

```cpp
#include <hip/hip_runtime.h>
#include <hip/hip_cooperative_groups.h>
#include <stdint.h>
#include <stdio.h>
namespace cg = cooperative_groups;

#ifndef DUP_MASK
#define DUP_MASK 0u
#endif
#ifndef DUP_SYNC
#define DUP_SYNC 0
#endif
#ifndef MEGA
#define MEGA 1
#endif

#define DI __device__ __forceinline__
typedef unsigned short bf16_t;
typedef __attribute__((ext_vector_type(8))) short bf16x8;
typedef __attribute__((ext_vector_type(16))) float f32x16;
typedef __attribute__((ext_vector_type(4))) float f32x4;
typedef __attribute__((ext_vector_type(4))) unsigned u32x4;
typedef __attribute__((ext_vector_type(2))) unsigned u32x2;
typedef __bf16 bf2_t __attribute__((ext_vector_type(2)));
typedef float f2_t __attribute__((ext_vector_type(2)));

#define MFMA32(a, b, c) __builtin_amdgcn_mfma_f32_32x32x16_bf16(__builtin_bit_cast(bf16x8, (a)), __builtin_bit_cast(bf16x8, (b)), (c), 0, 0, 0)
#define MFMA16(a, b, c) __builtin_amdgcn_mfma_f32_16x16x32_bf16(__builtin_bit_cast(bf16x8, (a)), __builtin_bit_cast(bf16x8, (b)), (c), 0, 0, 0)

constexpr int T = 32768, S = 4096, NBATCH = 8, DM = 1024, DFF = 2816;
constexpr float EPS = 1e-6f;
constexpr float LOG2E = 1.4426950408889634f;

DI int threadIdx_x_raw() { return (int)__builtin_amdgcn_workitem_id_x(); }
DI unsigned pack2(float a, float b) { f2_t f = {a, b}; bf2_t r = __builtin_convertvector(f, bf2_t); return __builtin_bit_cast(unsigned, r); }
DI float bflo(unsigned u) { return __uint_as_float(u << 16); }
DI float bfhi(unsigned u) { return __uint_as_float(u & 0xffff0000u); }
DI float bf2f(bf16_t v) { return __uint_as_float(((unsigned)v) << 16); }
DI bf16_t f2bf(float x) { return (bf16_t)(pack2(x, 0.f) & 0xffffu); }
DI float ex2(float x) { return __builtin_amdgcn_exp2f(x); }
DI int tid512() { int t = threadIdx_x_raw(); asm volatile("" : "+v"(t)); return t; }
DI int tidx() { return tid512() & 255; }
DI int vhalf() { return __builtin_amdgcn_readfirstlane(threadIdx_x_raw() >> 8); }
DI int vbid() { return 2 * (int)blockIdx.x + vhalf(); }
DI int vgrid() { return 2 * (int)gridDim.x; }
DI int crow(int reg, int h) { return (reg & 3) + 8 * (reg >> 2) + 4 * h; }
DI u32x4 ldg16(const void* p) { return *(const u32x4*)p; }
DI u32x4 zero4() { u32x4 z = {0u, 0u, 0u, 0u}; return z; }
DI int clampi(int v, int lo, int hi) { return v < lo ? lo : (v > hi ? hi : v); }

constexpr size_t SZ_WT_IN0 = (size_t)1952 * 1024 * 2, SZ_WT_QUP = (size_t)768 * 256 * 2, SZ_WT_KVUP = (size_t)1024 * 128 * 2,
                 SZ_WT_SQ = (size_t)1024 * 1024 * 2, SZ_WT_GU = (size_t)5632 * 1024 * 2, SZ_WT_DOWN = (size_t)1024 * 2816 * 2,
                 SZ_WT_IN1 = (size_t)3584 * 1024 * 2, SZ_ROPEA = (size_t)4096 * 16 * 8, SZ_ROPER = (size_t)4096 * 64 * 8,
                 SZ_FILT = (size_t)512 * 8192 * 2;
constexpr size_t OFF_WT_IN0 = 0;
constexpr size_t OFF_WT_QUP = OFF_WT_IN0 + SZ_WT_IN0;
constexpr size_t OFF_WT_KVUP = OFF_WT_QUP + SZ_WT_QUP;
constexpr size_t OFF_WT_OUT0 = OFF_WT_KVUP + SZ_WT_KVUP;
constexpr size_t OFF_WT_GU0 = OFF_WT_OUT0 + SZ_WT_SQ;
constexpr size_t OFF_WT_GU1 = OFF_WT_GU0 + SZ_WT_GU;
constexpr size_t OFF_WT_DN0 = OFF_WT_GU1 + SZ_WT_GU;
constexpr size_t OFF_WT_DN1 = OFF_WT_DN0 + SZ_WT_DOWN;
constexpr size_t OFF_WT_IN1 = OFF_WT_DN1 + SZ_WT_DOWN;
constexpr size_t OFF_WT_OUT1 = OFF_WT_IN1 + SZ_WT_IN1;
constexpr size_t OFF_ROPEA = OFF_WT_OUT1 + SZ_WT_SQ;
constexpr size_t OFF_ROPER = OFF_ROPEA + SZ_ROPEA;
constexpr size_t OFF_FILT = OFF_ROPER + SZ_ROPER;
constexpr size_t OFF_H = OFF_FILT + SZ_FILT;
constexpr size_t SZ_H = (size_t)T * 1024 * 2;
constexpr size_t OFF_AB = OFF_H + SZ_H;
constexpr size_t OFF_R = OFF_AB + SZ_H;
constexpr size_t OFF_P = OFF_R;
constexpr size_t OFF_QM = OFF_P + (size_t)T * 1952 * 2;
constexpr size_t OFF_KF = OFF_QM + (size_t)T * 768 * 2;
constexpr size_t OFF_VTM = OFF_KF + (size_t)T * 768 * 2;
constexpr size_t OFF_VTN = OFF_VTM + (size_t)T * 512 * 2;
constexpr size_t END_L0 = OFF_VTN + (size_t)T * 512 * 2;
constexpr size_t OFF_HID = OFF_R;
constexpr size_t OFF_M = OFF_R + (size_t)T * 2816 * 2;
constexpr size_t END_FFN = OFF_M + SZ_H;
constexpr size_t OFF_RQ = OFF_R;
constexpr size_t OFF_RK = OFF_RQ + (size_t)T * 512 * 2;
constexpr size_t OFF_RKT = OFF_RK + (size_t)T * 512 * 2;
constexpr size_t OFF_RVT = OFF_RKT + (size_t)T * 512 * 2;
constexpr size_t OFF_RG = OFF_RVT + (size_t)T * 512 * 2;
constexpr size_t OFF_HY = OFF_RG + (size_t)T * 512 * 2;
constexpr size_t OFF_KVF = OFF_HY + (size_t)T * 1536 * 2;
constexpr size_t OFF_KVB = OFF_KVF + (size_t)1024 * 16384 * 2;
constexpr size_t END_L1 = OFF_KVB + (size_t)1024 * 16384 * 2;
constexpr size_t HB_UT = 0;
constexpr size_t HB_YT = (size_t)512 * 8 * 4096 * 2;
constexpr size_t WS_NEED = END_L1 > END_L0 ? (END_L1 > END_FFN ? END_L1 : END_FFN) : (END_L0 > END_FFN ? END_L0 : END_FFN);
constexpr size_t OFF_BAR = (WS_NEED + 255) & ~(size_t)255;
constexpr size_t BAR_BYTES = 64 * 256;
static_assert(OFF_BAR + BAR_BYTES <= (size_t)512 * 1024 * 1024, "workspace too large");

struct Params {
  const float *x, *mix_pre, *mix_post, *ffn_pre, *ffn_post, *w_gate, *w_up, *ffn_conv, *w_down;
  const float *a_w_in, *a_q_norm, *a_w_q_up, *a_kv_norm, *a_w_kv_up, *a_rpb, *a_w_out;
  const float *c_w_in, *c_decay_f, *c_decay_b, *c_short, *f_w1, *f_b1, *f_w2, *f_b2, *f_w3, *f_b3, *f_w4, *f_freq, *hy_bias, *c_w_out;
  float* out;
  char* ws;
  char* hbuf;
};

constexpr int SMEM_BYTES = 73728;

constexpr int GLD = 72;
constexpr int CLD = 132;
template <class AL, class BL, class EP>
DI void gemm_tile(AL al, BL bl, EP ep, int K, char* smem) {
  bf16_t* sA = (bf16_t*)smem;
  bf16_t* sB = sA + 2 * 128 * GLD;
  const int tid = tidx(), lane = tid & 63, w = tid >> 6, wm = w >> 1, wn = w & 1, r = lane & 31, h = lane >> 5;
  const int lrow = tid >> 3, lck = tid & 7;
  f32x16 acc[2][2];
#pragma unroll
  for (int i = 0; i < 2; ++i)
#pragma unroll
    for (int j = 0; j < 2; ++j)
#pragma unroll
      for (int q = 0; q < 16; ++q) acc[i][j][q] = 0.f;
  u32x4 ra0[4], rb0[4], ra1[4], rb1[4];
  const int KT = K >> 6;
#define G_LOAD(RA, RB, kt_) { _Pragma("unroll") for (int i = 0; i < 4; ++i) { RA[i] = al(lrow + 32 * i, (kt_) * 64 + lck * 8); RB[i] = bl(lrow + 32 * i, (kt_) * 64 + lck * 8); } }
#define G_STORE(RA, RB, buf_) { bf16_t* nA = sA + (buf_) * 128 * GLD; bf16_t* nB = sB + (buf_) * 128 * GLD; _Pragma("unroll") for (int i = 0; i < 4; ++i) { \
      *(u32x4*)(nA + (lrow + 32 * i) * GLD + lck * 8) = RA[i]; *(u32x4*)(nB + (lrow + 32 * i) * GLD + lck * 8) = RB[i]; } }
#define G_COMPUTE(buf_) { const bf16_t* cA = sA + (buf_) * 128 * GLD + (64 * wm + r) * GLD + 8 * h; const bf16_t* cB = sB + (buf_) * 128 * GLD + (64 * wn + r) * GLD + 8 * h; \
    _Pragma("unroll") for (int ks = 0; ks < 4; ++ks) { \
      u32x4 a0 = *(const u32x4*)(cA + ks * 16); u32x4 a1 = *(const u32x4*)(cA + 32 * GLD + ks * 16); \
      u32x4 b0 = *(const u32x4*)(cB + ks * 16); u32x4 b1 = *(const u32x4*)(cB + 32 * GLD + ks * 16); \
      acc[0][0] = MFMA32(a0, b0, acc[0][0]); acc[0][1] = MFMA32(a0, b1, acc[0][1]); \
      acc[1][0] = MFMA32(a1, b0, acc[1][0]); acc[1][1] = MFMA32(a1, b1, acc[1][1]); } }
  G_LOAD(ra0, rb0, 0);
  if (KT > 1) G_LOAD(ra1, rb1, 1);
  __syncthreads();
  G_STORE(ra0, rb0, 0);
  __syncthreads();
  for (int kt = 0; kt < KT; kt += 2) {
    if (kt + 2 < KT) G_LOAD(ra0, rb0, kt + 2);
    __builtin_amdgcn_sched_barrier(0);
    G_COMPUTE(0);
    __builtin_amdgcn_sched_barrier(0);
    if (kt + 1 < KT) G_STORE(ra1, rb1, 1);
    __syncthreads();
    if (kt + 1 >= KT) break;
    if (kt + 3 < KT) G_LOAD(ra1, rb1, kt + 3);
    __builtin_amdgcn_sched_barrier(0);
    G_COMPUTE(1);
    __builtin_amdgcn_sched_barrier(0);
    if (kt + 2 < KT) G_STORE(ra0, rb0, 0);
    __syncthreads();
  }
#undef G_LOAD
#undef G_STORE
#undef G_COMPUTE
  float* sC = (float*)smem;
#pragma unroll
  for (int i = 0; i < 2; ++i)
#pragma unroll
    for (int j = 0; j < 2; ++j)
#pragma unroll
      for (int q = 0; q < 16; ++q) sC[(64 * wm + 32 * i + crow(q, h)) * CLD + 64 * wn + 32 * j + r] = acc[i][j][q];
  __syncthreads();
  ep(sC);
}

struct Sched { int xs, nx, rank, minloc; };
DI int sched_tile(const Sched& sc, int round, int MT, int NT, int& mt, int& nt) {
  const int total = MT * NT;
  const int per = (total + sc.nx - 1) / sc.nx;
  const int off = round * sc.minloc;
  if (off >= per) return 2;
  if (sc.rank >= sc.minloc) return 1;
  int L = off + sc.rank;
  if (L >= per) return 1;
  L += sc.xs * per;
  if (L >= total) return 1;
  for (int c0 = 0; c0 < NT; c0 += 8) {
    const int w = NT - c0 < 8 ? NT - c0 : 8;
    const int cnt = MT * w;
    if (L < cnt) { mt = L / w; nt = c0 + L - mt * w; return 0; }
    L -= cnt;
  }
  return 1;
}

constexpr int BLD = 264;
constexpr int SMEM_HALF = 73728;
constexpr int SMEM_TOTAL = 2 * SMEM_HALF;
template <class AL, class BL, class EP>
DI void gemm_tile256(AL al, BL bl, EP ep, int K, char* smem) {
  bf16_t* sA = (bf16_t*)smem;
  bf16_t* sB = sA + 2 * 256 * GLD;
  const int tid = tid512(), lane = tid & 63, w = tid >> 6, wm = w >> 2, wn = w & 3, r = lane & 31, h = lane >> 5;
  const int lrow = tid >> 3, lck = tid & 7;
  f32x16 acc[4][2];
#pragma unroll
  for (int i = 0; i < 4; ++i)
#pragma unroll
    for (int j = 0; j < 2; ++j)
#pragma unroll
      for (int q = 0; q < 16; ++q) acc[i][j][q] = 0.f;
  u32x4 ra[4], rb[4];
  const int KT = K >> 6;
#define G_LOADA(kt_) { _Pragma("unroll") for (int i = 0; i < 4; ++i) ra[i] = al(lrow + 64 * i, (kt_) * 64 + lck * 8); }
#define G_LOADB(kt_) { _Pragma("unroll") for (int i = 0; i < 4; ++i) rb[i] = bl(lrow + 64 * i, (kt_) * 64 + lck * 8); }
#define G_STOREA(buf_) { bf16_t* nA = sA + (buf_) * 256 * GLD; _Pragma("unroll") for (int i = 0; i < 4; ++i) *(u32x4*)(nA + (lrow + 64 * i) * GLD + lck * 8) = ra[i]; }
#define G_STOREB(buf_) { bf16_t* nB = sB + (buf_) * 256 * GLD; _Pragma("unroll") for (int i = 0; i < 4; ++i) *(u32x4*)(nB + (lrow + 64 * i) * GLD + lck * 8) = rb[i]; }
#define G_COMPUTE_KS(buf_, ks) { const bf16_t* cA = sA + (buf_) * 256 * GLD + (128 * wm + r) * GLD + 8 * h; const bf16_t* cB = sB + (buf_) * 256 * GLD + (64 * wn + r) * GLD + 8 * h; \
      u32x4 b0 = *(const u32x4*)(cB + (ks) * 16); u32x4 b1 = *(const u32x4*)(cB + 32 * GLD + (ks) * 16); \
      _Pragma("unroll") for (int i = 0; i < 4; ++i) { u32x4 a = *(const u32x4*)(cA + 32 * i * GLD + (ks) * 16); \
        acc[i][0] = MFMA32(b0, a, acc[i][0]); acc[i][1] = MFMA32(b1, a, acc[i][1]); } }
#define G_STEP(cur_, kt_) { \
    if ((kt_) + 1 < KT) G_LOADA((kt_) + 1); \
    __builtin_amdgcn_sched_barrier(0); \
    G_COMPUTE_KS(cur_, 0); \
    __builtin_amdgcn_sched_barrier(0); \
    if ((kt_) + 1 < KT) G_STOREB((cur_) ^ 1); \
    if ((kt_) + 2 < KT) G_LOADB((kt_) + 2); \
    __builtin_amdgcn_sched_barrier(0); \
    G_COMPUTE_KS(cur_, 1); G_COMPUTE_KS(cur_, 2); \
    __builtin_amdgcn_sched_barrier(0); \
    if ((kt_) + 1 < KT) G_STOREA((cur_) ^ 1); \
    __builtin_amdgcn_sched_barrier(0); \
    G_COMPUTE_KS(cur_, 3); \
    __syncthreads(); }
  G_LOADA(0); G_LOADB(0);
  __syncthreads();
  G_STOREA(0); G_STOREB(0);
  if (KT > 1) G_LOADB(1);
  __syncthreads();
  for (int kt = 0; kt < KT; kt += 2) {
    G_STEP(0, kt);
    if (kt + 1 >= KT) break;
    G_STEP(1, kt + 1);
  }
#undef G_LOADA
#undef G_LOADB
#undef G_STOREA
#undef G_STOREB
#undef G_COMPUTE_KS
#undef G_STEP
  if constexpr (EP::kBf16) {
    bf16_t* sCb = (bf16_t*)smem;
#pragma unroll
    for (int i = 0; i < 4; ++i)
#pragma unroll
      for (int j = 0; j < 2; ++j)
#pragma unroll
        for (int g = 0; g < 4; ++g) {
          u32x2 v = {pack2(acc[i][j][4 * g], acc[i][j][4 * g + 1]), pack2(acc[i][j][4 * g + 2], acc[i][j][4 * g + 3])};
          *(u32x2*)(sCb + (128 * wm + 32 * i + r) * BLD + 64 * wn + 32 * j + 8 * g + 4 * h) = v;
        }
    __syncthreads();
    ep(sCb);
  } else {
    float* sC = (float*)smem;
#pragma unroll
    for (int pass = 0; pass < 2; ++pass) {
      if (pass) __syncthreads();
      if ((wn >> 1) == pass) {
#pragma unroll
        for (int i = 0; i < 4; ++i)
#pragma unroll
          for (int j = 0; j < 2; ++j)
#pragma unroll
            for (int g = 0; g < 4; ++g) {
              f32x4 v = {acc[i][j][4 * g], acc[i][j][4 * g + 1], acc[i][j][4 * g + 2], acc[i][j][4 * g + 3]};
              *(f32x4*)(sC + (128 * wm + 32 * i + r) * CLD + 64 * (wn & 1) + 32 * j + 8 * g + 4 * h) = v;
            }
      }
      __syncthreads();
      ep(sC, pass);
    }
  }
}

struct LoadRows {
  const bf16_t* base; int ld; int row0; int nrows;
  DI u32x4 operator()(int r, int k) const {
    int row = row0 + r;
    row = row < nrows ? row : nrows - 1;
    return ldg16(base + (size_t)row * ld + k);
  }
};

DI void store8(bf16_t* dst, const float* v) {
  u32x4 o; o[0] = pack2(v[0], v[1]); o[1] = pack2(v[2], v[3]); o[2] = pack2(v[4], v[5]); o[3] = pack2(v[6], v[7]);
  *(u32x4*)dst = o;
}
DI void ld8f(const float* s, float* v) {
  f32x4 a = *(const f32x4*)s, b = *(const f32x4*)(s + 4);
  v[0] = a[0]; v[1] = a[1]; v[2] = a[2]; v[3] = a[3]; v[4] = b[0]; v[5] = b[1]; v[6] = b[2]; v[7] = b[3];
}

DI void ld8b(const bf16_t* p, float* v) {
  u32x4 u = *(const u32x4*)p;
#pragma unroll
  for (int q = 0; q < 4; ++q) { v[2 * q] = bflo(u[q]); v[2 * q + 1] = bfhi(u[q]); }
}
struct EpStore {
  bf16_t* dst; int ld; int m0; int n0; int N;
  DI void operator()(const float* sC) const {
    for (int id = tidx(); id < 2048; id += 256) {
      int row = id >> 4, c8 = (id & 15) * 8;
      if (n0 + c8 < N) { float v[8]; ld8f(sC + row * CLD + c8, v); store8(dst + (size_t)(m0 + row) * ld + n0 + c8, v); }
    }
  }
};

DI void transpose_tile(const float* __restrict__ src, bf16_t* __restrict__ dst, int K, int N, const float* kscale, int mode, int tile, char* smem) {
  float* sm = (float*)smem;
  const int ntn = (N + 63) >> 6;
  const int tk = tile / ntn, tn = tile - tk * ntn, k0 = tk * 64, n0 = tn * 64, tid = tidx();
  __syncthreads();
#pragma unroll 4
  for (int i = 0; i < 16; ++i) {
    int k = (tid >> 6) + 4 * i, n = n0 + (tid & 63);
    float v = (n < N) ? __builtin_nontemporal_load(&src[(size_t)(k0 + k) * N + n]) : 0.f;
    if (kscale) v *= kscale[k0 + k];
    sm[k * 65 + (tid & 63)] = v;
  }
  __syncthreads();
#pragma unroll
  for (int i = 0; i < 2; ++i) {
    int nl = (tid >> 3) + 32 * i, n = n0 + nl, kc = (tid & 7) * 8;
    if (n < N) {
      float v[8];
#pragma unroll
      for (int j = 0; j < 8; ++j) v[j] = sm[(kc + j) * 65 + nl];
      int drow = n;
      if (mode == 1) drow = (n >> 6) * 128 + (n & 63);
      if (mode == 2) drow = (n >> 6) * 128 + 64 + (n & 63);
      store8(dst + (size_t)drow * K + k0 + kc, v);
    }
  }
}

DI void rms_row_to_bf16(const float* __restrict__ xr, const float* __restrict__ g, bf16_t* __restrict__ hr, int lane) {
  f32x4 v[4]; float ss = 0.f;
#pragma unroll
  for (int i = 0; i < 4; ++i) { v[i] = *(const f32x4*)(xr + lane * 4 + 256 * i);     ss += v[i][0] * v[i][0] + v[i][1] * v[i][1] + v[i][2] * v[i][2] + v[i][3] * v[i][3]; }
#pragma unroll
  for (int o = 32; o >= 1; o >>= 1) ss += __shfl_xor(ss, o);
  float rs = rsqrtf(ss * (1.f / 1024.f) + EPS);
#pragma unroll
  for (int i = 0; i < 4; ++i) {
    f32x4 gg = *(const f32x4*)(g + lane * 4 + 256 * i);
    u32x2 o; o[0] = pack2(v[i][0] * rs * gg[0], v[i][1] * rs * gg[1]); o[1] = pack2(v[i][2] * rs * gg[2], v[i][3] * rs * gg[3]);
    *(u32x2*)(hr + lane * 4 + 256 * i) = o;
  }
}

DI void sincos_acc(float ang, float& c, float& s) {
  double a = (double)ang;
  double n = rint(a * 0.15915494309189535);
  float r = (float)(a - n * 6.283185307179586);
  c = cosf(r); s = sinf(r);
}

DI void hyena_filter_pos(const Params& p, int t, int w, int lane, float* sz, float* sh0, float* sh1) {
  const float tn = (float)t / 4095.f;
  const float wt = (6.283185307179586f * (float)t) / 4096.f;
  if (lane < 33) {
    float z;
    if (lane == 0) z = tn;
    else {
      int i = (lane - 1) & 15;
      float f = 1e-4f + (float)i * ((15.f - 1e-4f) / 15.f);
      float fw = f * wt;
      z = (lane <= 16) ? cosf(fw) : -sinf(fw);
    }
    sz[w * 40 + lane] = z;
  }
  __syncthreads();
  const float fr = p.f_freq[lane];
  float a = p.f_b1[lane];
#pragma unroll 1
  for (int i = 0; i < 33; ++i) a += sz[w * 40 + i] * p.f_w1[i * 64 + lane];
  sh0[w * 64 + lane] = sinf(fr * a);
  __syncthreads();
  a = p.f_b2[lane];
#pragma unroll 4
  for (int i = 0; i < 64; ++i) a += sh0[w * 64 + i] * p.f_w2[i * 64 + lane];
  sh1[w * 64 + lane] = sinf(fr * a);
  __syncthreads();
  a = p.f_b3[lane];
#pragma unroll 4
  for (int i = 0; i < 64; ++i) a += sh1[w * 64 + i] * p.f_w3[i * 64 + lane];
  __syncthreads();
  sh0[w * 64 + lane] = sinf(fr * a);
  __syncthreads();
  bf16_t* filt = (bf16_t*)(p.ws + OFF_FILT);
  const float dmin = logf(1e-2f) / 1.5f, dmax = logf(1e-2f) / 0.3f;
#pragma unroll 1
  for (int i = 0; i < 16; ++i) {
    int n = lane + 64 * i;
    float o = 0.f;
#pragma unroll 4
    for (int k = 0; k < 64; ++k) o += sh0[w * 64 + k] * p.f_w4[k * 1024 + n];
    int c = n & 511;
    float delta = dmin + (float)c * ((dmax - dmin) / 511.f);
    float win = expf(-tn * fabsf(delta));
    o *= win;
    if (n < 512) {
      if (t == 0) o += p.hy_bias[c];
      filt[(size_t)c * 8192 + 4096 + t] = f2bf(o);
    } else {
      if (t == 0) filt[(size_t)c * 8192] = 0;
      else filt[(size_t)c * 8192 + 4096 - t] = f2bf(o);
    }
  }
  __syncthreads();
}

constexpr int TR_T0 = 16 * 31, TR_T1 = 4 * 12, TR_T2 = 2 * 16, TR_T3 = 16 * 16, TR_TG = 16 * 44, TR_TD = 44 * 16, TR_TI1 = 16 * 56;
constexpr int TR_TOTAL = TR_T0 + TR_T1 + TR_T2 + TR_T3 + 4 * TR_TG + 2 * TR_TD + TR_TI1 + TR_T3;
constexpr int P0_ROPE = (4096 * 80) / 256;
constexpr int P0_FILT = 1024;
constexpr int P0_NORM = T / 4;
constexpr int P0_ITEMS = TR_TOTAL + P0_ROPE + P0_FILT + P0_NORM;

DI void phase0(const Params& p, char* smem) {
  const int tid = tidx(), lane = tid & 63, w = tid >> 6;
  for (int it = vbid(); it < P0_ITEMS; it += vgrid()) {
    if (it < TR_TOTAL) {
      int t = it;
      char* ws = p.ws;
      const float* src = p.a_w_in; size_t doff = OFF_WT_IN0; int K = 1024, N = 1952, mode = 0; const float* sc = nullptr;
      bool found = false;
      if (t < TR_T0) found = true; else t -= TR_T0;
      if (!found) { if (t < TR_T1) { found = true; src = p.a_w_q_up; doff = OFF_WT_QUP; K = 256; N = 768; sc = p.a_q_norm; } else t -= TR_T1; }
      if (!found) { if (t < TR_T2) { found = true; src = p.a_w_kv_up; doff = OFF_WT_KVUP; K = 128; N = 1024; sc = p.a_kv_norm; } else t -= TR_T2; }
      if (!found) { if (t < TR_T3) { found = true; src = p.a_w_out; doff = OFF_WT_OUT0; K = 1024; N = 1024; } else t -= TR_T3; }
      if (!found) { if (t < TR_TG) { found = true; src = p.w_gate; doff = OFF_WT_GU0; K = 1024; N = 2816; mode = 1; } else t -= TR_TG; }
      if (!found) { if (t < TR_TG) { found = true; src = p.w_gate + (size_t)1024 * 2816; doff = OFF_WT_GU1; K = 1024; N = 2816; mode = 1; } else t -= TR_TG; }
      if (!found) { if (t < TR_TG) { found = true; src = p.w_up; doff = OFF_WT_GU0; K = 1024; N = 2816; mode = 2; } else t -= TR_TG; }
      if (!found) { if (t < TR_TG) { found = true; src = p.w_up + (size_t)1024 * 2816; doff = OFF_WT_GU1; K = 1024; N = 2816; mode = 2; } else t -= TR_TG; }
      if (!found) { if (t < TR_TD) { found = true; src = p.w_down; doff = OFF_WT_DN0; K = 2816; N = 1024; } else t -= TR_TD; }
      if (!found) { if (t < TR_TD) { found = true; src = p.w_down + (size_t)1024 * 2816; doff = OFF_WT_DN1; K = 2816; N = 1024; } else t -= TR_TD; }
      if (!found) { if (t < TR_TI1) { found = true; src = p.c_w_in; doff = OFF_WT_IN1; K = 1024; N = 3584; } else t -= TR_TI1; }
      if (!found) { src = p.c_w_out; doff = OFF_WT_OUT1; K = 1024; N = 1024; }
      transpose_tile(src, (bf16_t*)(ws + doff), K, N, sc, mode, t, smem);
      continue;
    }
    int j = it - TR_TOTAL;
    if (j < P0_ROPE) {
      int idx = j * 256 + tid;
      if (idx < 4096 * 16) {
        int pos = idx >> 4, i = idx & 15;
        float inv = (float)exp2(-(double)(2 * i) / 32.0 * 13.287712379549449);
        float ang = (float)pos * inv, c, s; sincos_acc(ang, c, s);
        ((float2*)(p.ws + OFF_ROPEA))[idx] = make_float2(c, s);
      } else {
        int k = idx - 4096 * 16; int pos = k >> 6, i = k & 63;
        float inv = (float)exp2(-(double)(2 * i) / 128.0 * 13.287712379549449);
        float ang = (float)pos * inv, c, s; sincos_acc(ang, c, s);
        ((float2*)(p.ws + OFF_ROPER))[k] = make_float2(c, s);
      }
      continue;
    }
    j -= P0_ROPE;
    if (j < P0_FILT) {
      float* sf = (float*)smem;
      __syncthreads();
      hyena_filter_pos(p, j * 4 + w, w, lane, sf, sf + 160, sf + 160 + 256);
      continue;
    }
    j -= P0_FILT;
    {
      int row = j * 4 + w;
      rms_row_to_bf16(p.x + (size_t)row * 1024, p.mix_pre, (bf16_t*)(p.hbuf) + (size_t)row * 1024, lane);
    }
  }
}

template <int XIN, int XOUT>
DI void phase_resid(const void* xin_, void* xout_, const bf16_t* __restrict__ m, const float* __restrict__ gpost,
                    const float* __restrict__ gnext, bf16_t* __restrict__ hout) {
  const int lane = tidx() & 63, w = tidx() >> 6;
  for (int it = vbid(); it < T / 8; it += vgrid()) {
    const int row0 = it * 8 + w * 2;
    float mv[2][16], xv[2][16], ss[2], s2[2];
#pragma unroll
    for (int rr = 0; rr < 2; ++rr) {
      const size_t ro = (size_t)(row0 + rr) * 1024;
#pragma unroll
      for (int i = 0; i < 4; ++i) {
        u32x2 u = __builtin_nontemporal_load((const u32x2*)(m + ro + lane * 4 + 256 * i));
        mv[rr][4 * i] = bflo(u[0]); mv[rr][4 * i + 1] = bfhi(u[0]); mv[rr][4 * i + 2] = bflo(u[1]); mv[rr][4 * i + 3] = bfhi(u[1]);
        if (XIN == 0) {
          f32x4 xo = __builtin_nontemporal_load((const f32x4*)((const float*)xin_ + ro + lane * 4 + 256 * i));
          xv[rr][4 * i] = xo[0]; xv[rr][4 * i + 1] = xo[1]; xv[rr][4 * i + 2] = xo[2]; xv[rr][4 * i + 3] = xo[3];
        } else {
          const u32x2* xp_ = (const u32x2*)((const bf16_t*)xin_ + ro + lane * 4 + 256 * i);
          u32x2 xu = (XOUT == 0) ? __builtin_nontemporal_load(xp_) : *xp_;
          xv[rr][4 * i] = bflo(xu[0]); xv[rr][4 * i + 1] = bfhi(xu[0]); xv[rr][4 * i + 2] = bflo(xu[1]); xv[rr][4 * i + 3] = bfhi(xu[1]);
        }
      }
    }
#pragma unroll
    for (int rr = 0; rr < 2; ++rr) {
      ss[rr] = 0.f;
#pragma unroll
      for (int q = 0; q < 16; ++q) ss[rr] += mv[rr][q] * mv[rr][q];
    }
#pragma unroll
    for (int o = 32; o >= 1; o >>= 1) { ss[0] += __shfl_xor(ss[0], o); ss[1] += __shfl_xor(ss[1], o); }
#pragma unroll
    for (int rr = 0; rr < 2; ++rr) {
      const size_t ro = (size_t)(row0 + rr) * 1024;
      const float rs = rsqrtf(ss[rr] * (1.f / 1024.f) + EPS);
      s2[rr] = 0.f;
#pragma unroll
      for (int i = 0; i < 4; ++i) {
        f32x4 gg = *(const f32x4*)(gpost + lane * 4 + 256 * i);
#pragma unroll
        for (int q = 0; q < 4; ++q) { float v = xv[rr][4 * i + q] + mv[rr][4 * i + q] * rs * gg[q]; xv[rr][4 * i + q] = v; s2[rr] += v * v; }
        if (XOUT == 0) {
          f32x4 o = {xv[rr][4 * i], xv[rr][4 * i + 1], xv[rr][4 * i + 2], xv[rr][4 * i + 3]};
          __builtin_nontemporal_store(o, (f32x4*)((float*)xout_ + ro + lane * 4 + 256 * i));
        } else {
          u32x2 o = {pack2(xv[rr][4 * i], xv[rr][4 * i + 1]), pack2(xv[rr][4 * i + 2], xv[rr][4 * i + 3])};
          *(u32x2*)((bf16_t*)xout_ + ro + lane * 4 + 256 * i) = o;
        }
      }
    }
    if (hout) {
#pragma unroll
      for (int o = 32; o >= 1; o >>= 1) { s2[0] += __shfl_xor(s2[0], o); s2[1] += __shfl_xor(s2[1], o); }
#pragma unroll
      for (int rr = 0; rr < 2; ++rr) {
        const float r2 = rsqrtf(s2[rr] * (1.f / 1024.f) + EPS);
#pragma unroll
        for (int i = 0; i < 4; ++i) {
          f32x4 gg = *(const f32x4*)(gnext + lane * 4 + 256 * i);
          u32x2 o; o[0] = pack2(xv[rr][4 * i] * r2 * gg[0], xv[rr][4 * i + 1] * r2 * gg[1]); o[1] = pack2(xv[rr][4 * i + 2] * r2 * gg[2], xv[rr][4 * i + 3] * r2 * gg[3]);
          *(u32x2*)(hout + (size_t)(row0 + rr) * 1024 + lane * 4 + 256 * i) = o;
        }
      }
    }
  }
}

DI void phase_gemm_plain(const bf16_t* A, int lda, const bf16_t* Wt, int K, int N, bf16_t* C, int ldc, char* smem) {
  const int NT = (N + 127) >> 7, MT = T / 128;
  for (int t = vbid(); t < MT * NT; t += vgrid()) {
    const int mt = t / NT, nt = t - mt * NT;
    LoadRows al{A, lda, mt * 128, T};
    LoadRows bl{Wt, K, nt * 128, N};
    EpStore ep{C, ldc, mt * 128, nt * 128, N};
    gemm_tile(al, bl, ep, K, smem);
  }
}

struct EpStore256 {
  static constexpr bool kBf16 = true;
  bf16_t* dst; int ld; int m0; int n0; int N;
  DI void operator()(const bf16_t* sCb) const {
    for (int id = tid512(); id < 8192; id += 512) {
      int row = id >> 5, c8 = (id & 31) * 8, n = n0 + c8;
      if (n < N) *(u32x4*)(dst + (size_t)(m0 + row) * ld + n) = *(const u32x4*)(sCb + row * BLD + c8);
    }
  }
};
DI void phase_gemm_plain256(const Sched& sc, const bf16_t* A, int lda, const bf16_t* Wt, int K, int N, bf16_t* C, int ldc, char* smem) {
  const int NT = (N + 255) >> 8, MT = T / 256;
  for (int round = 0;; ++round) {
    int mt = 0, nt = 0;
    const int st = sched_tile(sc, round, MT, NT, mt, nt);
    if (st == 2) break;
    if (st == 1) continue;
    LoadRows al{A, lda, mt * 256, T};
    LoadRows bl{Wt, K, nt * 256, N};
    EpStore256 ep{C, ldc, mt * 256, nt * 256, N};
    gemm_tile256(al, bl, ep, K, smem);
  }
}

DI void row_rs(const bf16_t* base, int ld, int m0, int ncols, float* srs) {
  const int tid = tidx(), row = tid >> 1, half = tid & 1;
  const bf16_t* pr = base + (size_t)(m0 + row) * ld + half * (ncols >> 1);
  float ss = 0.f;
  for (int c = 0; c < (ncols >> 1); c += 8) {
    u32x4 u = ldg16(pr + c);
#pragma unroll
    for (int q = 0; q < 4; ++q) { float a = bflo(u[q]), b = bfhi(u[q]); ss += a * a + b * b; }
  }
  ss += __shfl_xor(ss, 1);
  if (half == 0) srs[row] = rsqrtf(ss / (float)ncols + EPS);
}

struct EpQup {
  const Params* p; int m0; int n0;
  DI void operator()(float* sC) const {
    float* srs = sC + 128 * CLD;
    const bf16_t* P = (const bf16_t*)(p->ws + OFF_P);
    row_rs(P, 1952, m0, 256, srs);
    __syncthreads();
    const float2* rope = (const float2*)(p->ws + OFF_ROPEA);
    bf16_t* Qm = (bf16_t*)(p->ws + OFF_QM);
    const float qs = 0.10206207261596575f * LOG2E;
    for (int id = tidx(); id < 2048; id += 256) {
      int row = id >> 4, c8 = (id & 15) * 8, n = n0 + c8;
      float v[8]; ld8f(sC + row * CLD + c8, v);
      int d = n % 96;
      if (d >= 64) {
        int pos = (m0 + row) & 4095;
        bool first = (d - 64) < 16;
        int i0 = (d - 64) & 15;
        float pv[8]; ld8f(sC + row * CLD + c8 + (first ? 16 : -16), pv);
#pragma unroll
        for (int j = 0; j < 8; ++j) {
          float2 cs = rope[pos * 16 + i0 + j];
          v[j] = first ? (v[j] * cs.x - pv[j] * cs.y) : (v[j] * cs.x + pv[j] * cs.y);
        }
      }
      float sc = srs[row] * qs;
#pragma unroll
      for (int j = 0; j < 8; ++j) v[j] *= sc;
      store8(Qm + (size_t)(m0 + row) * 768 + n, v);
    }
  }
};

struct EpKVup {
  const Params* p; int m0; int nt;
  DI void operator()(float* sC) const {
    float* srs = sC + 128 * CLD;
    const bf16_t* P = (const bf16_t*)(p->ws + OFF_P);
    row_rs(P + 256, 1952, m0, 128, srs);
    __syncthreads();
    bf16_t* Kf = (bf16_t*)(p->ws + OFF_KF);
    bf16_t* Vt = (bf16_t*)(p->ws + OFF_VTM);
    const int hh = nt;
    for (int id = tidx(); id < 1024; id += 256) {
      int row = id >> 3, c8 = (id & 7) * 8;
      float v[8]; ld8f(sC + row * CLD + c8, v);
      float sc = srs[row];
#pragma unroll
      for (int j = 0; j < 8; ++j) v[j] *= sc;
      store8(Kf + (size_t)(m0 + row) * 768 + hh * 96 + c8, v);
    }
    const int b = m0 >> 12, s0 = m0 & 4095;
    for (int id = tidx(); id < 1024; id += 256) {
      int col = id & 63, rch = id >> 6;
      float v[8];
#pragma unroll
      for (int j = 0; j < 8; ++j) v[j] = sC[(rch * 8 + j) * CLD + 64 + col] * srs[rch * 8 + j];
      store8(Vt + ((size_t)(b * 8 + hh) * 64 + col) * 4096 + s0 + rch * 8, v);
    }
    if (nt == 0) {
      const float2* rope = (const float2*)(p->ws + OFF_ROPEA);
      for (int id = tidx(); id < 512; id += 256) {
        int row = id >> 2, c4 = id & 3;
        int pos = (m0 + row) & 4095;
        u32x4 u = ldg16(P + (size_t)(m0 + row) * 1952 + 384 + c4 * 8);
        u32x4 q = ldg16(P + (size_t)(m0 + row) * 1952 + 384 + (c4 ^ 2) * 8);
        bool first = c4 < 2;
        int i0 = (c4 & 1) * 8;
        float v[8];
#pragma unroll
        for (int j = 0; j < 8; ++j) {
          float a = (j & 1) ? bfhi(u[j >> 1]) : bflo(u[j >> 1]);
          float o = (j & 1) ? bfhi(q[j >> 1]) : bflo(q[j >> 1]);
          float2 cs = rope[pos * 16 + i0 + j];
          v[j] = first ? (a * cs.x - o * cs.y) : (a * cs.x + o * cs.y);
        }
#pragma unroll
        for (int h8 = 0; h8 < 8; ++h8) store8(Kf + (size_t)(m0 + row) * 768 + h8 * 96 + 64 + c4 * 8, v);
      }
    }
  }
};

DI void transpose_bf16_64(const bf16_t* __restrict__ src, int lds_, bf16_t* __restrict__ dst, int ldd, char* smem) {
  bf16_t* sT = (bf16_t*)smem;
  const int tid = tidx();
  __syncthreads();
#pragma unroll
  for (int i = 0; i < 2; ++i) {
    int row = (tid >> 3) + 32 * i, ck = tid & 7;
    u32x4 u = ldg16(src + (size_t)row * lds_ + ck * 8);
#pragma unroll
    for (int j = 0; j < 8; ++j) { unsigned wv = u[j >> 1]; sT[(ck * 8 + j) * 72 + row] = (bf16_t)((j & 1) ? (wv >> 16) : (wv & 0xffffu)); }
  }
  __syncthreads();
#pragma unroll
  for (int i = 0; i < 2; ++i) {
    int row = (tid >> 3) + 32 * i, ck = tid & 7;
    *(u32x4*)(dst + (size_t)row * ldd + ck * 8) = *(const u32x4*)(sT + row * 72 + ck * 8);
  }
}

constexpr int P2_QUP = 256 * 6, P2_KVUP = 256 * 8, P2_VT = 512 * 8;
DI void phase2(const Params& p, char* smem) {
  const bf16_t* P = (const bf16_t*)(p.ws + OFF_P);
  for (int it = vbid(); it < P2_QUP + P2_KVUP + P2_VT; it += vgrid()) {
    if (it < P2_QUP) {
      int mt = it / 6, nt = it - mt * 6;
      LoadRows al{P, 1952, mt * 128, T};
      LoadRows bl{(const bf16_t*)(p.ws + OFF_WT_QUP), 256, nt * 128, 768};
      EpQup ep{&p, mt * 128, nt * 128};
      gemm_tile(al, bl, ep, 256, smem);
    } else if (it < P2_QUP + P2_KVUP) {
      int j = it - P2_QUP; int mt = j >> 3, nt = j & 7;
      LoadRows al{P + 256, 1952, mt * 128, T};
      LoadRows bl{(const bf16_t*)(p.ws + OFF_WT_KVUP), 128, nt * 128, 1024};
      EpKVup ep{&p, mt * 128, nt};
      gemm_tile(al, bl, ep, 128, smem);
    } else {
      int j = it - P2_QUP - P2_KVUP; int tt = j >> 3, hh = j & 7;
      int b = tt >> 6, s0 = (tt & 63) * 64;
      transpose_bf16_64(P + (size_t)(tt * 64) * 1952 + 1440 + hh * 64, 1952,
                        (bf16_t*)(p.ws + OFF_VTN) + ((size_t)(b * 8 + hh) * 64) * 4096 + s0, 4096, smem);
    }
  }
}

template <int DQK, bool NA>
DI void attn_unit(const bf16_t* __restrict__ Qb, int ldq, const bf16_t* __restrict__ Kb, int ldk, const bf16_t* __restrict__ Vt,
                  bf16_t* __restrict__ Ob, int ldo, int u, float sc, const float* __restrict__ rpb_h, char* smem) {
  constexpr int KS = DQK + 8;
  constexpr int NKC = DQK / 8;
  constexpr int KCH = 64 * NKC;
  constexpr int NDS = DQK / 16;
  bf16_t* sK = (bf16_t*)smem;
  bf16_t* sV = sK + 2 * 64 * KS;
  float* sBias = (float*)(sV + 2 * 64 * 72);
  const int tid = tid512(), lane = tid & 63, w = tid >> 6, r = lane & 31, h = lane >> 5;
  int t_lo = 0, t_hi = 63;
  int rq = 0, rs = 0, cq = 0, cs = 0;
  if (NA) {
    int r0 = 4 * u;
    t_lo = clampi(r0 - 4, 0, 56);
    t_hi = clampi(r0 + 3 - 4, 0, 56) + 7;
    rq = r0 + (w >> 1); rs = clampi(rq - 4, 0, 56);
    cq = 32 * (w & 1) + r; cs = clampi(cq - 8, 0, 48);
  }
  __syncthreads();
  if (NA) { for (int i = tid; i < 15 * 31; i += 512) sBias[i] = rpb_h[i] * LOG2E; }
  u32x4 qf[NDS];
  {
    const bf16_t* qp = Qb + (size_t)(256 * u + 32 * w + r) * ldq + 8 * h;
#pragma unroll
    for (int ds = 0; ds < NDS; ++ds) qf[ds] = ldg16(qp + 16 * ds);
  }
  u32x4 kreg[2], vreg;
  const bool k2 = (tid + 512) < KCH;
  const int krow0 = tid / NKC, kck0 = tid - krow0 * NKC;
  const int krow1 = (tid + 512) / NKC, kck1 = (tid + 512) - krow1 * NKC;
  const int vrow = tid >> 3, vck = tid & 7;
  auto load_tile = [&](int kt) {
    kreg[0] = ldg16(Kb + (size_t)(64 * kt + krow0) * ldk + kck0 * 8);
    if (k2) kreg[1] = ldg16(Kb + (size_t)(64 * kt + krow1) * ldk + kck1 * 8);
    vreg = ldg16(Vt + (size_t)vrow * 4096 + 64 * kt + vck * 8);
  };
  auto store_tile = [&](int buf) {
    bf16_t* dK = sK + buf * 64 * KS; bf16_t* dV = sV + buf * 64 * 72;
    *(u32x4*)(dK + krow0 * KS + kck0 * 8) = kreg[0];
    if (k2) *(u32x4*)(dK + krow1 * KS + kck1 * 8) = kreg[1];
    const int g = vck >> 1, odd = vck & 1;
    u32x2 lo = {vreg[0], vreg[1]}, hi = {vreg[2], vreg[3]};
    *(u32x2*)(dV + vrow * 72 + g * 16 + (odd ? 4 : 0)) = lo;
    *(u32x2*)(dV + vrow * 72 + g * 16 + (odd ? 12 : 8)) = hi;
  };
  load_tile(t_lo);
  store_tile(0);
  __syncthreads();
  f32x16 o0, o1;
#pragma unroll
  for (int q = 0; q < 16; ++q) { o0[q] = 0.f; o1[q] = 0.f; }
  float m_run = -INFINITY, l_run = 0.f;
  for (int kt = t_lo; kt <= t_hi; ++kt) {
    const int cur = (kt - t_lo) & 1;
    const bool more = kt < t_hi;
    if (more) load_tile(kt + 1);
    bool active = true;
    if (NA) active = (kt >= rs) && (kt < rs + 8);
    if (active) {
      const bf16_t* cK = sK + cur * 64 * KS + r * KS + 8 * h;
      const bf16_t* cV = sV + cur * 64 * 72 + r * 72 + 8 * h;
      f32x16 s0, s1;
      {
        const f32x16 zero16 = {0.f, 0.f, 0.f, 0.f, 0.f, 0.f, 0.f, 0.f, 0.f, 0.f, 0.f, 0.f, 0.f, 0.f, 0.f, 0.f};
        u32x4 k0 = *(const u32x4*)(cK);
        u32x4 k1 = *(const u32x4*)(cK + 32 * KS);
        s0 = MFMA32(k0, qf[0], zero16);
        s1 = MFMA32(k1, qf[0], zero16);
      }
#pragma unroll
      for (int ds = 1; ds < NDS; ++ds) {
        u32x4 k0 = *(const u32x4*)(cK + ds * 16);
        u32x4 k1 = *(const u32x4*)(cK + 32 * KS + ds * 16);
        s0 = MFMA32(k0, qf[ds], s0);
        s1 = MFMA32(k1, qf[ds], s1);
      }
      if (NA) {
        const int brow = (kt - rq + 7) * 31;
#pragma unroll
        for (int q = 0; q < 16; ++q) {
          int kc0 = crow(q, h), kc1 = 32 + kc0;
          bool v0 = (kc0 >= cs) && (kc0 < cs + 16), v1 = (kc1 >= cs) && (kc1 < cs + 16);
          float b0 = v0 ? sBias[brow + kc0 - cq + 15] : 0.f;
          float b1 = v1 ? sBias[brow + kc1 - cq + 15] : 0.f;
          s0[q] = v0 ? (s0[q] * sc + b0) : -INFINITY;
          s1[q] = v1 ? (s1[q] * sc + b1) : -INFINITY;
        }
      }
      float mx = s0[0];
#pragma unroll
      for (int q = 1; q < 16; ++q) mx = fmaxf(mx, s0[q]);
#pragma unroll
      for (int q = 0; q < 16; ++q) mx = fmaxf(mx, s1[q]);
      mx = fmaxf(mx, __shfl_xor(mx, 32));
      if (__builtin_amdgcn_ballot_w64((mx - m_run) > 8.f) != 0ull) {
        const float m_new = fmaxf(m_run, mx);
        const float alpha = ex2(m_run - m_new);
        m_run = m_new;
        l_run *= alpha;
#pragma unroll
        for (int q = 0; q < 16; ++q) { o0[q] *= alpha; o1[q] *= alpha; }
      }
      const f2_t nm = {-m_run, -m_run};
      f2_t ls2 = {0.f, 0.f};
#pragma unroll
      for (int q = 0; q < 16; q += 2) {
        f2_t a = {s0[q], s0[q + 1]}, b = {s1[q], s1[q + 1]};
        a = a + nm; b = b + nm;
        a[0] = ex2(a[0]); a[1] = ex2(a[1]); b[0] = ex2(b[0]); b[1] = ex2(b[1]);
        s0[q] = a[0]; s0[q + 1] = a[1]; s1[q] = b[0]; s1[q + 1] = b[1];
        ls2 = ls2 + a; ls2 = ls2 + b;
      }
      l_run += ls2[0] + ls2[1];
      u32x4 pf[4];
#pragma unroll
      for (int s = 0; s < 2; ++s) {
        pf[s][0] = pack2(s0[8 * s], s0[8 * s + 1]); pf[s][1] = pack2(s0[8 * s + 2], s0[8 * s + 3]);
        pf[s][2] = pack2(s0[8 * s + 4], s0[8 * s + 5]); pf[s][3] = pack2(s0[8 * s + 6], s0[8 * s + 7]);
        pf[2 + s][0] = pack2(s1[8 * s], s1[8 * s + 1]); pf[2 + s][1] = pack2(s1[8 * s + 2], s1[8 * s + 3]);
        pf[2 + s][2] = pack2(s1[8 * s + 4], s1[8 * s + 5]); pf[2 + s][3] = pack2(s1[8 * s + 6], s1[8 * s + 7]);
      }
#pragma unroll
      for (int ks = 0; ks < 4; ++ks) {
        u32x4 v0 = *(const u32x4*)(cV + ks * 16);
        u32x4 v1 = *(const u32x4*)(cV + 32 * 72 + ks * 16);
        o0 = MFMA32(v0, pf[ks], o0);
        o1 = MFMA32(v1, pf[ks], o1);
      }
    }
    if (more) store_tile(cur ^ 1);
    __syncthreads();
  }
  l_run += __shfl_xor(l_run, 32);
  const float inv = 1.f / l_run;
  bf16_t* op = Ob + (size_t)(256 * u + 32 * w + r) * ldo;
#pragma unroll
  for (int g = 0; g < 4; ++g) {
    u32x2 a = {pack2(o0[4 * g] * inv, o0[4 * g + 1] * inv), pack2(o0[4 * g + 2] * inv, o0[4 * g + 3] * inv)};
    u32x2 b = {pack2(o1[4 * g] * inv, o1[4 * g + 1] * inv), pack2(o1[4 * g + 2] * inv, o1[4 * g + 3] * inv)};
    *(u32x2*)(op + 8 * g + 4 * h) = a;
    *(u32x2*)(op + 32 + 8 * g + 4 * h) = b;
  }
}

DI void phase3(const Sched& sc, const Params& p, char* smem) {
  bf16_t* AB = (bf16_t*)(p.ws + OFF_AB);
  int P = sc.minloc / 16; P = P < 1 ? 1 : P;
  const bool act = sc.rank < P * 16;
  const int u = sc.rank & 15;
  for (int kind = 0; kind < 2; ++kind) {
    for (int round = 0;; ++round) {
      const int pair0 = (round * sc.nx + sc.xs) * P;
      if (pair0 >= 64) break;
      const int pair = pair0 + (sc.rank >> 4);
      if (!act || pair >= 64) continue;
      const int hh = pair & 7, b = pair >> 3;
      if (kind == 0) {
        attn_unit<96, false>((const bf16_t*)(p.ws + OFF_QM) + (size_t)b * 4096 * 768 + hh * 96, 768,
                             (const bf16_t*)(p.ws + OFF_KF) + (size_t)b * 4096 * 768 + hh * 96, 768,
                             (const bf16_t*)(p.ws + OFF_VTM) + (size_t)(b * 8 + hh) * 64 * 4096,
                             AB + (size_t)b * 4096 * 1024 + hh * 64, 1024, u, 1.f, nullptr, smem);
      } else {
        const bf16_t* Pm = (const bf16_t*)(p.ws + OFF_P) + (size_t)b * 4096 * 1952;
        attn_unit<64, true>(Pm + 416 + hh * 64, 1952, Pm + 928 + hh * 64, 1952,
                            (const bf16_t*)(p.ws + OFF_VTN) + (size_t)(b * 8 + hh) * 64 * 4096,
                            AB + (size_t)b * 4096 * 1024 + 512 + hh * 64, 1024, u, 0.125f * LOG2E, p.a_rpb + hh * 15 * 31, smem);
      }
    }
  }
}

struct LoadFfnA {
  const bf16_t* H; int b; int p0;
  DI u32x4 operator()(int r, int k) const {
    int pos = clampi(p0 + r, 0, 4095);
    return ldg16(H + ((size_t)b * 4096 + pos) * 1024 + k);
  }
};
struct EpFfnUp {
  const float* conv; bf16_t* hid; int b; int p0; int c0;
  DI void operator()(const float* sC) const {
    for (int id = tidx(); id < 126 * 8; id += 256) {
      int rr = id >> 3, c8 = (id & 7) * 8, row = rr + 1, pos = p0 + row;
      if (pos < 4096) {
        float gm[8], g0[8], gp[8], uu[8], w0[8], w1[8], w2[8], v[8];
        ld8f(sC + (row - 1) * CLD + c8, gm); ld8f(sC + row * CLD + c8, g0); ld8f(sC + (row + 1) * CLD + c8, gp); ld8f(sC + row * CLD + 64 + c8, uu);
        if (pos == 0) { _Pragma("unroll") for (int j = 0; j < 8; ++j) gm[j] = 0.f; }
        if (pos == 4095) { _Pragma("unroll") for (int j = 0; j < 8; ++j) gp[j] = 0.f; }
        ld8f(conv + c0 + c8, w0); ld8f(conv + DFF + c0 + c8, w1); ld8f(conv + 2 * DFF + c0 + c8, w2);
#pragma unroll
        for (int j = 0; j < 8; ++j) {
          float g = w0[j] * gm[j] + w1[j] * g0[j] + w2[j] * gp[j];
          float y = 0.7978845608028654f * (g + 0.044715f * g * g * g);
          float e = __expf(-2.f * y);
          v[j] = g * __builtin_amdgcn_rcpf(1.f + e) * uu[j];
        }
        store8(hid + ((size_t)b * 4096 + pos) * DFF + c0 + c8, v);
      }
    }
  }
};
DI void phase_ffn_up(const Params& p, int layer, char* smem) {
  const bf16_t* H = (const bf16_t*)(p.hbuf);
  const bf16_t* Wt = (const bf16_t*)(p.ws + (layer ? OFF_WT_GU1 : OFF_WT_GU0));
  for (int t = vbid(); t < 264 * 44; t += vgrid()) {
    int mt = t / 44, nt = t - mt * 44, b = mt / 33, j = mt - b * 33;
    LoadFfnA al{H, b, 126 * j - 1};
    LoadRows bl{Wt, 1024, nt * 128, 5632};
    EpFfnUp ep{p.ffn_conv + (size_t)layer * 3 * DFF, (bf16_t*)(p.ws + OFF_HID), b, 126 * j - 1, nt * 64};
    gemm_tile(al, bl, ep, 1024, smem);
  }
}

constexpr size_t OFF_HG = OFF_M;
constexpr size_t OFF_HU = OFF_M + (size_t)128 * 4 * DFF * 2;
DI float gelu_gate(float g, float u) {
  float y = g * (-2.3022081985f - 0.1029432396f * g * g);
  return g * __builtin_amdgcn_rcpf(1.f + ex2(y)) * u;
}
struct EpFfnUp256 {
  static constexpr bool kBf16 = true;
  const float* conv; bf16_t* hid; bf16_t* hg; bf16_t* hu; int mt; int c0;
  DI void operator()(const bf16_t* sCb) const {
    const int t = tid512(), hf = (t >> 3) & 1, c8 = (t & 7) * 8;
    const int cb = c0 + 64 * hf;
    const bf16_t* base = sCb + 128 * hf;
    float w0[8], w1[8], w2[8];
    ld8f(conv + cb + c8, w0); ld8f(conv + DFF + cb + c8, w1); ld8f(conv + 2 * DFF + cb + c8, w2);
    for (int rr = t >> 4; rr < 254; rr += 32) {
      const int row = rr + 1;
      float gm[8], g0[8], gp[8], uu[8], v[8];
      ld8b(base + (row - 1) * BLD + c8, gm); ld8b(base + row * BLD + c8, g0); ld8b(base + (row + 1) * BLD + c8, gp); ld8b(base + row * BLD + 64 + c8, uu);
#pragma unroll
      for (int j = 0; j < 8; ++j) v[j] = gelu_gate(w0[j] * gm[j] + w1[j] * g0[j] + w2[j] * gp[j], uu[j]);
      store8(hid + ((size_t)mt * 256 + row) * DFF + cb + c8, v);
    }
    if (t < 16 * 6) {
      const int which = t >> 4;
      const int row = which < 4 ? ((which & 1) + 254 * (which >> 1)) : (which == 4 ? 0 : 255);
      const u32x4 val = *(const u32x4*)(base + row * BLD + (which < 4 ? 0 : 64) + c8);
      bf16_t* dst = which < 4 ? hg + ((size_t)mt * 4 + which) * DFF : hu + ((size_t)mt * 2 + (which - 4)) * DFF;
      *(u32x4*)(dst + cb + c8) = val;
    }
  }
};
DI void ffn_fixup(const Params& p, int layer) {
  const float* conv = p.ffn_conv + (size_t)layer * 3 * DFF;
  const bf16_t* hg = (const bf16_t*)(p.ws + OFF_HG);
  const bf16_t* hu = (const bf16_t*)(p.ws + OFF_HU);
  bf16_t* hid = (bf16_t*)(p.ws + OFF_HID);
  for (int id = (int)blockIdx.x * 512 + tid512(); id < 128 * 2 * 352; id += (int)gridDim.x * 512) {
    const int c = (id % 352) * 8, e = (id / 352) & 1, mt = id / 704;
    float gm[8], g0[8], gp[8], uu[8], w0[8], w1[8], w2[8], v[8];
    ld8f(conv + c, w0); ld8f(conv + DFF + c, w1); ld8f(conv + 2 * DFF + c, w2);
    int row;
    if (e == 0) {
      row = 0;
      if ((mt & 15) != 0) ld8b(hg + ((size_t)(mt - 1) * 4 + 3) * DFF + c, gm); else { _Pragma("unroll") for (int j = 0; j < 8; ++j) gm[j] = 0.f; }
      ld8b(hg + ((size_t)mt * 4 + 0) * DFF + c, g0); ld8b(hg + ((size_t)mt * 4 + 1) * DFF + c, gp); ld8b(hu + ((size_t)mt * 2 + 0) * DFF + c, uu);
    } else {
      row = 255;
      ld8b(hg + ((size_t)mt * 4 + 2) * DFF + c, gm); ld8b(hg + ((size_t)mt * 4 + 3) * DFF + c, g0); ld8b(hu + ((size_t)mt * 2 + 1) * DFF + c, uu);
      if ((mt & 15) != 15) ld8b(hg + ((size_t)(mt + 1) * 4 + 0) * DFF + c, gp); else { _Pragma("unroll") for (int j = 0; j < 8; ++j) gp[j] = 0.f; }
    }
#pragma unroll
    for (int j = 0; j < 8; ++j) v[j] = gelu_gate(w0[j] * gm[j] + w1[j] * g0[j] + w2[j] * gp[j], uu[j]);
    store8(hid + ((size_t)mt * 256 + row) * DFF + c, v);
  }
}
DI void phase_ffn_up256(const Sched& sc, const Params& p, int layer, char* smem) {
  const bf16_t* H = (const bf16_t*)(p.hbuf);
  const bf16_t* Wt = (const bf16_t*)(p.ws + (layer ? OFF_WT_GU1 : OFF_WT_GU0));
  for (int round = 0;; ++round) {
    int mt = 0, nt = 0;
    const int st = sched_tile(sc, round, 128, 22, mt, nt);
    if (st == 2) break;
    if (st == 1) continue;
    LoadRows al{H, 1024, mt * 256, T};
    LoadRows bl{Wt, 1024, nt * 256, 5632};
    EpFfnUp256 ep{p.ffn_conv + (size_t)layer * 3 * DFF, (bf16_t*)(p.ws + OFF_HID), (bf16_t*)(p.ws + OFF_HG), (bf16_t*)(p.ws + OFF_HU), mt, nt * 128};
    gemm_tile256(al, bl, ep, 1024, smem);
  }
}

struct EpIn1 {
  const Params* p; int m0; int nt; float rscale;
  DI void operator()(float* sC) const {
    const int b = m0 >> 12, s0 = m0 & 4095;
    char* ws = p->ws;
    if (nt < 8) {
      const float2* rope = (const float2*)(ws + OFF_ROPER);
      const float sc = (nt >= 4) ? 0.08838834764831845f : 1.f;
      for (int id = tidx(); id < 128 * 64; id += 256) {
        int row = id >> 6, i = id & 63;
        float2 cs = rope[(size_t)(s0 + row) * 64 + i];
        float x1 = sC[row * CLD + i], x2 = sC[row * CLD + i + 64];
        sC[row * CLD + i] = (x1 * cs.x - x2 * cs.y) * sc;
        sC[row * CLD + i + 64] = (x1 * cs.y + x2 * cs.x) * sc;
      }
      __syncthreads();
    }
    bf16_t* nat = nullptr; int ldn = 512, coff = 0;
    if (nt < 4) { nat = (bf16_t*)(ws + OFF_RQ); coff = nt * 128; }
    else if (nt < 8) { nat = (bf16_t*)(ws + OFF_RK); coff = (nt - 4) * 128; }
    else if (nt < 12) { nat = nullptr; }
    else if (nt < 16) { nat = (bf16_t*)(ws + OFF_RG); coff = (nt - 12) * 128; }
    else { nat = (bf16_t*)(ws + OFF_HY); ldn = 1536; coff = (nt - 16) * 128; }
    if (nat) {
      for (int id = tidx(); id < 2048; id += 256) {
        int row = id >> 4, c8 = (id & 15) * 8;
        float v[8]; ld8f(sC + row * CLD + c8, v);
        store8(nat + (size_t)(m0 + row) * ldn + coff + c8, v);
      }
    }
    if (nt >= 4 && nt < 12) {
      bf16_t* tp = (bf16_t*)(ws + (nt < 8 ? OFF_RKT : OFF_RVT));
      int hh = (nt - 4) & 3;
      for (int id = tidx(); id < 128 * 16; id += 256) {
        int col = id & 127, rch = id >> 7;
        float v[8];
#pragma unroll
        for (int j = 0; j < 8; ++j) v[j] = sC[(rch * 8 + j) * CLD + col];
        store8(tp + ((size_t)(b * 4 + hh) * 128 + col) * 4096 + s0 + rch * 8, v);
      }
    }
  }
};
DI void phase_in1(const Params& p, char* smem) {
  const bf16_t* H = (const bf16_t*)(p.hbuf);
  const bf16_t* Wt = (const bf16_t*)(p.ws + OFF_WT_IN1);
  for (int t = vbid(); t < 256 * 28; t += vgrid()) {
    int mt = t / 28, nt = t - mt * 28;
    LoadRows al{H, 1024, mt * 128, T};
    LoadRows bl{Wt, 1024, nt * 128, 3584};
    EpIn1 ep{&p, mt * 128, nt, 1.f};
    gemm_tile(al, bl, ep, 1024, smem);
  }
}

struct EpIn1_256 {
  static constexpr bool kBf16 = true;
  const Params* p; int m0; int nt2;
  DI void operator()(bf16_t* sCb) const {
    const int b = m0 >> 12, s0 = m0 & 4095;
    char* ws = p->ws;
    if (nt2 < 4) {
      const float2* rope = (const float2*)(ws + OFF_ROPER);
      const float sc = (nt2 >= 2) ? 0.08838834764831845f : 1.f;
      for (int id = tid512(); id < 256 * 128; id += 512) {
        int row = id >> 7, hf = (id >> 6) & 1, i = id & 63;
        float2 cs = rope[(size_t)(s0 + row) * 64 + i];
        bf16_t* q1 = sCb + row * BLD + 128 * hf + i;
        float x1 = bf2f(q1[0]), x2 = bf2f(q1[64]);
        q1[0] = f2bf((x1 * cs.x - x2 * cs.y) * sc);
        q1[64] = f2bf((x1 * cs.y + x2 * cs.x) * sc);
      }
      __syncthreads();
    }
#pragma unroll 1
    for (int hf = 0; hf < 2; ++hf) {
      const int nt = 2 * nt2 + hf;
      const bf16_t* base = sCb + 128 * hf;
      bf16_t* nat = nullptr; int ldn = 512, coff = 0;
      if (nt < 4) { nat = (bf16_t*)(ws + OFF_RQ); coff = nt * 128; }
      else if (nt < 8) { nat = (bf16_t*)(ws + OFF_RK); coff = (nt - 4) * 128; }
      else if (nt < 12) { nat = nullptr; }
      else if (nt < 16) { nat = (bf16_t*)(ws + OFF_RG); coff = (nt - 12) * 128; }
      else { nat = (bf16_t*)(ws + OFF_HY); ldn = 1536; coff = (nt - 16) * 128; }
      if (nat) {
        for (int id = tid512(); id < 4096; id += 512) {
          int row = id >> 4, c8 = (id & 15) * 8;
          *(u32x4*)(nat + (size_t)(m0 + row) * ldn + coff + c8) = *(const u32x4*)(base + row * BLD + c8);
        }
      }
      if (nt >= 4 && nt < 12) {
        bf16_t* tp = (bf16_t*)(ws + (nt < 8 ? OFF_RKT : OFF_RVT));
        int hh = (nt - 4) & 3;
        for (int id = tid512(); id < 128 * 32; id += 512) {
          int col = id & 127, rch = id >> 7;
          unsigned short e[8];
#pragma unroll
          for (int j = 0; j < 8; ++j) e[j] = base[(rch * 8 + j) * BLD + col];
          u32x4 o = {(unsigned)e[0] | ((unsigned)e[1] << 16), (unsigned)e[2] | ((unsigned)e[3] << 16), (unsigned)e[4] | ((unsigned)e[5] << 16), (unsigned)e[6] | ((unsigned)e[7] << 16)};
          *(u32x4*)(tp + ((size_t)(b * 4 + hh) * 128 + col) * 4096 + s0 + rch * 8) = o;
        }
      }
    }
  }
};
DI void phase_in1_256(const Sched& sc, const Params& p, char* smem) {
  const bf16_t* H = (const bf16_t*)(p.hbuf);
  const bf16_t* Wt = (const bf16_t*)(p.ws + OFF_WT_IN1);
  for (int round = 0;; ++round) {
    int mt = 0, nt = 0;
    const int st = sched_tile(sc, round, 128, 14, mt, nt);
    if (st == 2) break;
    if (st == 1) continue;
    LoadRows al{H, 1024, mt * 256, T};
    LoadRows bl{Wt, 1024, nt * 256, 3584};
    EpIn1_256 ep{&p, mt * 256, nt};
    gemm_tile256(al, bl, ep, 1024, smem);
  }
}

DI float log_sigmoid(float x) { return fminf(x, 0.f) - log1pf(expf(-fabsf(x))); }

struct LoadKtScaled {
  const bf16_t* base; float l2g; int mode;
  DI u32x4 operator()(int r, int k) const {
    u32x4 u = ldg16(base + (size_t)r * 4096 + k);
    u32x4 o;
#pragma unroll
    for (int q = 0; q < 4; ++q) {
      int c = k + 2 * q;
      float e0 = mode ? (float)c : (float)(127 - c), e1 = mode ? (float)(c + 1) : (float)(126 - c);
      o[q] = pack2(bflo(u[q]) * ex2(e0 * l2g), bfhi(u[q]) * ex2(e1 * l2g));
    }
    return o;
  }
};
struct LoadStrided { const bf16_t* base; DI u32x4 operator()(int r, int k) const { return ldg16(base + (size_t)r * 4096 + k); } };

DI void hyena_pre_tile(const Params& p, int item, char* smem) {
  const int tid = tidx();
  const int ct = item & 7, st = (item >> 3) & 63, b = item >> 9;
  const bf16_t* HY = (const bf16_t*)(p.ws + OFF_HY) + (size_t)b * 4096 * 1536;
  bf16_t* sT = (bf16_t*)smem;
  __syncthreads();
#pragma unroll
  for (int i = 0; i < 2; ++i) {
    int row = (tid >> 3) + 32 * i, ck = tid & 7, s = st * 64 + row, c = ct * 64 + ck * 8;
    float x1[8], vv[8];
#pragma unroll
    for (int j = 0; j < 8; ++j) { x1[j] = 0.f; vv[j] = 0.f; }
#pragma unroll
    for (int d = -1; d <= 1; ++d) {
      int ss = s + d;
      if (ss >= 0 && ss < 4096) {
        u32x4 a = ldg16(HY + (size_t)ss * 1536 + 512 + c), bb = ldg16(HY + (size_t)ss * 1536 + 1024 + c);
        float wa[8], wb[8]; ld8f(p.c_short + (d + 1) * 1536 + 512 + c, wa); ld8f(p.c_short + (d + 1) * 1536 + 1024 + c, wb);
#pragma unroll
        for (int q = 0; q < 4; ++q) {
          x1[2 * q] += wa[2 * q] * bflo(a[q]); x1[2 * q + 1] += wa[2 * q + 1] * bfhi(a[q]);
          vv[2 * q] += wb[2 * q] * bflo(bb[q]); vv[2 * q + 1] += wb[2 * q + 1] * bfhi(bb[q]);
        }
      }
    }
#pragma unroll
    for (int j = 0; j < 8; ++j) sT[(ck * 8 + j) * 72 + row] = f2bf(x1[j] * vv[j]);
  }
  __syncthreads();
  bf16_t* uT = (bf16_t*)(p.hbuf + HB_UT);
#pragma unroll
  for (int i = 0; i < 2; ++i) {
    int row = (tid >> 3) + 32 * i, ck = tid & 7;
    *(u32x4*)(uT + ((size_t)(ct * 64 + row) * 8 + b) * 4096 + st * 64 + ck * 8) = *(const u32x4*)(sT + row * 72 + ck * 8);
  }
}

struct EpKV {
  bf16_t* dst;
  DI void operator()(const float* sC) const {
    for (int id = tidx(); id < 2048; id += 256) {
      int row = id >> 4, c8 = (id & 15) * 8;
      float v[8]; ld8f(sC + row * CLD + c8, v); store8(dst + row * 128 + c8, v);
    }
  }
};

constexpr int P10_KV = 2048, P10_HY = 4096;
DI void phase10(const Params& p, char* smem) {
  for (int it = vbid(); it < P10_KV + P10_HY; it += vgrid()) {
    if (it < P10_KV) {
      int dir = it & 1, unit = it >> 1;
      int n = unit & 31, bh = unit >> 5, hh = bh & 3;
      float lg = log_sigmoid(dir ? p.c_decay_b[hh] : p.c_decay_f[hh]) * LOG2E;
      LoadStrided al{(const bf16_t*)(p.ws + OFF_RVT) + (size_t)bh * 128 * 4096 + n * 128};
      LoadKtScaled bl{(const bf16_t*)(p.ws + OFF_RKT) + (size_t)bh * 128 * 4096 + n * 128, lg, dir};
      EpKV ep{(bf16_t*)(p.ws + (dir ? OFF_KVB : OFF_KVF)) + (size_t)unit * 16384};
      gemm_tile(al, bl, ep, 128, smem);
    } else {
      hyena_pre_tile(p, it - P10_KV, smem);
    }
  }
}

DI void retention_scan_item(const Params& p, int item) {
  const int per_dir = 32 * 8192 / 256;
  int dir = item / per_dir, j = item - dir * per_dir;
  int idx2 = j * 256 + tidx();
  int bh = idx2 >> 13, e2 = idx2 & 8191, hh = bh & 3;
  float lg = log_sigmoid(dir ? p.c_decay_b[hh] : p.c_decay_f[hh]) * LOG2E;
  float G = ex2(128.f * lg);
  unsigned* base = (unsigned*)(p.ws + (dir ? OFF_KVB : OFF_KVF)) + (size_t)bh * 32 * 8192 + e2;
  float s0 = 0.f, s1 = 0.f;
  if (!dir) {
    for (int n = 0; n < 32; ++n) {
      unsigned v = base[(size_t)n * 8192];
      base[(size_t)n * 8192] = pack2(s0, s1);
      s0 = G * s0 + bflo(v); s1 = G * s1 + bfhi(v);
    }
  } else {
    for (int n = 31; n >= 0; --n) {
      unsigned v = base[(size_t)n * 8192];
      base[(size_t)n * 8192] = pack2(s0, s1);
      s0 = G * s0 + bflo(v); s1 = G * s1 + bfhi(v);
    }
  }
}

DI void hyena_conv_unit(const Params& p, int item, char* smem) {
  const int tid = tidx(), lane = tid & 63, w = tid >> 6;
  const int c = item >> 1, bh2 = item & 1, b = bh2 * 4 + w;
  bf16_t* sG0 = (bf16_t*)smem;
  bf16_t* sG1 = sG0 + 8200;
  bf16_t* sU = sG1 + 8200;
  const bf16_t* G = (const bf16_t*)(p.ws + OFF_FILT) + (size_t)c * 8192;
  __syncthreads();
  for (int x = tid; x < 8192; x += 256) {
    bf16_t v = G[8191 - x];
    sG0[x] = v;
    if (x >= 1) sG1[x - 1] = v;
  }
  if (tid == 0) sG1[8191] = 0;
  {
    const bf16_t* ub = (const bf16_t*)(p.hbuf + HB_UT) + ((size_t)c * 8 + b) * 4096;
    bf16_t* su = sU + w * 64 * 72;
#pragma unroll
    for (int i = 0; i < 8; ++i) { int id = lane + 64 * i; int row = id >> 3, ck = id & 7; *(u32x4*)(su + row * 72 + ck * 8) = ldg16(ub + row * 64 + ck * 8); }
  }
  __syncthreads();
  const int n = lane & 15, g = lane >> 4;
  const bf16_t* su = sU + w * 64 * 72;
  f32x4 acc[4][4];
#pragma unroll
  for (int i = 0; i < 4; ++i)
#pragma unroll
    for (int j = 0; j < 4; ++j) { acc[i][j][0] = 0.f; acc[i][j][1] = 0.f; acc[i][j][2] = 0.f; acc[i][j][3] = 0.f; }
  auto bfrag = [&](int E) -> u32x4 {
    int a = 4095 - 16 * E - n + 8 * g;
    const bf16_t* src = (a & 1) ? (sG1 + (a - 1)) : (sG0 + a);
    const unsigned* s32 = (const unsigned*)src;
    u32x4 o = {s32[0], s32[1], s32[2], s32[3]};
    return o;
  };
  for (int d = -63; d <= 63; ++d) {
#pragma unroll
    for (int kk = 0; kk < 2; ++kk) {
      u32x4 bfr[4];
#pragma unroll
      for (int nn = 0; nn < 4; ++nn) bfr[nn] = bfrag(4 * d + nn - 2 * kk);
#pragma unroll
      for (int rb = 0; rb < 4; ++rb) {
        if (d >= 16 * rb - 63 && d <= 16 * rb + 15) {
          int t1 = 16 * rb + n, s1 = t1 - d;
          u32x4 a = zero4();
          if (s1 >= 0 && s1 < 64) a = *(const u32x4*)(su + s1 * 72 + 32 * kk + 8 * g);
#pragma unroll
          for (int nn = 0; nn < 4; ++nn) acc[rb][nn] = MFMA16(a, bfr[nn], acc[rb][nn]);
        }
      }
    }
  }
  bf16_t* yT = (bf16_t*)(p.hbuf + HB_YT) + ((size_t)c * 8 + b) * 4096;
#pragma unroll
  for (int rb = 0; rb < 4; ++rb)
#pragma unroll
    for (int nn = 0; nn < 4; ++nn)
#pragma unroll
      for (int q = 0; q < 4; ++q) yT[(16 * rb + 4 * g + q) * 64 + 16 * nn + n] = f2bf(acc[rb][nn][q]);
}

constexpr int P11_SCAN = 2 * (32 * 8192 / 256), P11_CONV = 1024;
DI void phase11(const Params& p, char* smem) {
  for (int it = vbid(); it < P11_CONV + P11_SCAN; it += vgrid()) {
    if (it < P11_CONV) hyena_conv_unit(p, it, smem);
    else retention_scan_item(p, it - P11_CONV);
  }
}

DI void stage_tile128(bf16_t* sT, const bf16_t* __restrict__ src, size_t ld, bool perm) {
  const int tid = tidx();
  __syncthreads();
#pragma unroll
  for (int hlf = 0; hlf < 2; ++hlf) {
    u32x4 regs[4];
#pragma unroll
    for (int i = 0; i < 4; ++i) { int id = tid + 256 * (4 * hlf + i); int row = id >> 4, ck = id & 15; regs[i] = ldg16(src + (size_t)row * ld + ck * 8); }
#pragma unroll
    for (int i = 0; i < 4; ++i) {
      int id = tid + 256 * (4 * hlf + i); int row = id >> 4, ck = id & 15;
      if (!perm) *(u32x4*)(sT + row * 136 + ck * 8) = regs[i];
      else {
        int g = ck >> 1, odd = ck & 1;
        u32x2 lo = {regs[i][0], regs[i][1]}, hi = {regs[i][2], regs[i][3]};
        *(u32x2*)(sT + row * 136 + g * 16 + (odd ? 4 : 0)) = lo;
        *(u32x2*)(sT + row * 136 + g * 16 + (odd ? 12 : 8)) = hi;
      }
    }
  }
  __syncthreads();
}

DI void load_qf8(const bf16_t* __restrict__ qp, u32x4* qf) {
#pragma unroll
  for (int ds = 0; ds < 8; ++ds) qf[ds] = ldg16(qp + 16 * ds);
}
DI void retention_out_unit(const Params& p, int unit, char* smem) {
  const int tid = tidx(), lane = tid & 63, w = tid >> 6, r = lane & 31, h = lane >> 5;
  const int n = unit & 31, bh = unit >> 5, hh = bh & 3, b = bh >> 2;
  const size_t tok0 = (size_t)b * 4096 + n * 128;
  bf16_t* sT = (bf16_t*)smem;
  const float lgf = log_sigmoid(p.c_decay_f[hh]) * LOG2E, lgb = log_sigmoid(p.c_decay_b[hh]) * LOG2E;
  const bf16_t* qp = (const bf16_t*)(p.ws + OFF_RQ) + (tok0 + 32 * w + r) * 512 + hh * 128 + 8 * h;
  int cq = 32 * w + r;
  asm volatile("" : "+v"(cq));
  stage_tile128(sT, (const bf16_t*)(p.ws + OFF_RK) + tok0 * 512 + hh * 128, 512, false);
  u32x4 pf[8];
  {
    u32x4 qf[8];
    load_qf8(qp, qf);
#pragma unroll
    for (int mb = 0; mb < 4; ++mb) {
      f32x16 s;
#pragma unroll
      for (int q = 0; q < 16; ++q) s[q] = 0.f;
      const bf16_t* cK = sT + (32 * mb + r) * 136 + 8 * h;
#pragma unroll
      for (int ds = 0; ds < 8; ++ds) { u32x4 k = *(const u32x4*)(cK + 16 * ds); s = MFMA32(k, qf[ds], s); }
#pragma unroll
      for (int q = 0; q < 16; ++q) {
        int m = 32 * mb + crow(q, h);
        int diff = cq - m;
        float dec = (diff >= 0) ? ex2((float)diff * lgf) : ex2((float)(-diff) * lgb);
        s[q] *= dec;
      }
#pragma unroll
      for (int sx = 0; sx < 2; ++sx) {
        pf[2 * mb + sx][0] = pack2(s[8 * sx], s[8 * sx + 1]); pf[2 * mb + sx][1] = pack2(s[8 * sx + 2], s[8 * sx + 3]);
        pf[2 * mb + sx][2] = pack2(s[8 * sx + 4], s[8 * sx + 5]); pf[2 * mb + sx][3] = pack2(s[8 * sx + 6], s[8 * sx + 7]);
      }
    }
  }
  stage_tile128(sT, (const bf16_t*)(p.ws + OFF_RVT) + (size_t)bh * 128 * 4096 + n * 128, 4096, true);
  f32x16 o[4];
#pragma unroll
  for (int eb = 0; eb < 4; ++eb) {
#pragma unroll
    for (int q = 0; q < 16; ++q) o[eb][q] = 0.f;
    const bf16_t* cV = sT + (32 * eb + r) * 136 + 8 * h;
#pragma unroll
    for (int ks = 0; ks < 8; ++ks) { u32x4 v = *(const u32x4*)(cV + 16 * ks); o[eb] = MFMA32(v, pf[ks], o[eb]); }
  }
#pragma unroll 1
  for (int dir = 0; dir < 2; ++dir) {
    stage_tile128(sT, (const bf16_t*)(p.ws + (dir ? OFF_KVB : OFF_KVF)) + (size_t)unit * 16384, 128, false);
    u32x4 qf[8];
    load_qf8(qp, qf);
    const float xi = dir ? ex2((float)(128 - cq) * lgb) : ex2((float)(cq + 1) * lgf);
#pragma unroll
    for (int eb = 0; eb < 4; ++eb) {
      f32x16 t;
#pragma unroll
      for (int q = 0; q < 16; ++q) t[q] = 0.f;
      const bf16_t* cS = sT + (32 * eb + r) * 136 + 8 * h;
#pragma unroll
      for (int ds = 0; ds < 8; ++ds) { u32x4 sv = *(const u32x4*)(cS + 16 * ds); t = MFMA32(sv, qf[ds], t); }
#pragma unroll
      for (int q = 0; q < 16; ++q) o[eb][q] += xi * t[q];
    }
  }
  float ss = 0.f;
#pragma unroll
  for (int eb = 0; eb < 4; ++eb)
#pragma unroll
    for (int q = 0; q < 16; ++q) ss += o[eb][q] * o[eb][q];
  ss += __shfl_xor(ss, 32);
  const float rn = rsqrtf(ss * (1.f / 128.f) + EPS);
  const bf16_t* gp = (const bf16_t*)(p.ws + OFF_RG) + (tok0 + cq) * 512 + hh * 128;
  bf16_t* op = (bf16_t*)(p.ws + OFF_AB) + (tok0 + cq) * 1024 + hh * 128;
#pragma unroll
  for (int eb = 0; eb < 4; ++eb)
#pragma unroll
    for (int g4 = 0; g4 < 4; ++g4) {
      int e = 32 * eb + 8 * g4 + 4 * h;
      u32x2 gu = *(const u32x2*)(gp + e);
      float gv[4] = {bflo(gu[0]), bfhi(gu[0]), bflo(gu[1]), bfhi(gu[1])};
      float ov[4];
#pragma unroll
      for (int q = 0; q < 4; ++q) { float gg = gv[q]; float sl = gg * __builtin_amdgcn_rcpf(1.f + __expf(-gg)); ov[q] = o[eb][4 * g4 + q] * rn * sl; }
      u32x2 st = {pack2(ov[0], ov[1]), pack2(ov[2], ov[3])};
      *(u32x2*)(op + e) = st;
    }
}

DI void hyena_post_tile(const Params& p, int item, char* smem) {
  const int tid = tidx();
  const int ct = item & 7, st = (item >> 3) & 63, b = item >> 9;
  const bf16_t* HY = (const bf16_t*)(p.ws + OFF_HY) + (size_t)b * 4096 * 1536;
  const bf16_t* yT = (const bf16_t*)(p.hbuf + HB_YT);
  bf16_t* sT = (bf16_t*)smem;
  __syncthreads();
#pragma unroll
  for (int i = 0; i < 2; ++i) {
    int row = (tid >> 3) + 32 * i, ck = tid & 7;
    u32x4 u = ldg16(yT + ((size_t)(ct * 64 + row) * 8 + b) * 4096 + st * 64 + ck * 8);
#pragma unroll
    for (int j = 0; j < 8; ++j) { unsigned wv = u[j >> 1]; sT[(ck * 8 + j) * 72 + row] = (bf16_t)((j & 1) ? (wv >> 16) : (wv & 0xffffu)); }
  }
  __syncthreads();
  bf16_t* CD = (bf16_t*)(p.ws + OFF_AB);
#pragma unroll
  for (int i = 0; i < 2; ++i) {
    int row = (tid >> 3) + 32 * i, ck = tid & 7, s = st * 64 + row, c = ct * 64 + ck * 8;
    float x0[8];
#pragma unroll
    for (int j = 0; j < 8; ++j) x0[j] = 0.f;
#pragma unroll
    for (int d = -1; d <= 1; ++d) {
      int ss = s + d;
      if (ss >= 0 && ss < 4096) {
        u32x4 a = ldg16(HY + (size_t)ss * 1536 + c);
        float wa[8]; ld8f(p.c_short + (d + 1) * 1536 + c, wa);
#pragma unroll
        for (int q = 0; q < 4; ++q) { x0[2 * q] += wa[2 * q] * bflo(a[q]); x0[2 * q + 1] += wa[2 * q + 1] * bfhi(a[q]); }
      }
    }
    u32x4 y = *(const u32x4*)(sT + row * 72 + ck * 8);
    float v[8];
#pragma unroll
    for (int q = 0; q < 4; ++q) { v[2 * q] = bflo(y[q]) * x0[2 * q]; v[2 * q + 1] = bfhi(y[q]) * x0[2 * q + 1]; }
    store8(CD + ((size_t)b * 4096 + s) * 1024 + 512 + c, v);
  }
}

constexpr int P12_RET = 1024, P12_HY = 4096;
DI void phase12(const Params& p, char* smem) {
  for (int it = vbid(); it < P12_RET + P12_HY; it += vgrid()) {
    if (it < P12_RET) retention_out_unit(p, it, smem);
    else hyena_post_tile(p, it - P12_RET, smem);
  }
}

constexpr int NPHASE = 18;
DI void run_phase(const Sched& sc, const Params& p, int ph, char* smem_full) {
  char* ws = p.ws;
  char* smem = smem_full + vhalf() * SMEM_HALF;
  bf16_t* H = (bf16_t*)(p.hbuf);
  bf16_t* XB = (bf16_t*)(ws + OFF_H);
  bf16_t* AB = (bf16_t*)(ws + OFF_AB);
  bf16_t* M = (bf16_t*)(ws + OFF_M);
  bf16_t* HID = (bf16_t*)(ws + OFF_HID);
  switch (ph) {
    case 0: phase0(p, smem); break;
    case 1: phase_gemm_plain256(sc, H, 1024, (const bf16_t*)(ws + OFF_WT_IN0), 1024, 1952, (bf16_t*)(ws + OFF_P), 1952, smem_full); break;
    case 2: phase2(p, smem); break;
    case 3: phase3(sc, p, smem_full); break;
    case 4: phase_gemm_plain256(sc, AB, 1024, (const bf16_t*)(ws + OFF_WT_OUT0), 1024, 1024, M, 1024, smem_full); break;
    case 5: phase_resid<0, 1>(p.x, XB, M, p.mix_post, p.ffn_pre, H); break;
    case 6: phase_ffn_up256(sc, p, 0, smem_full); break;
    case 7: phase_gemm_plain256(sc, HID, DFF, (const bf16_t*)(ws + OFF_WT_DN0), DFF, 1024, M, 1024, smem_full); break;
    case 8: phase_resid<1, 1>(XB, XB, M, p.ffn_post, p.mix_pre + 1024, H); break;
    case 9: phase_in1_256(sc, p, smem_full); break;
    case 10: phase10(p, smem); break;
    case 11: phase11(p, smem); break;
    case 12: phase12(p, smem); break;
    case 13: phase_gemm_plain256(sc, AB, 1024, (const bf16_t*)(ws + OFF_WT_OUT1), 1024, 1024, M, 1024, smem_full); break;
    case 14: phase_resid<1, 1>(XB, XB, M, p.mix_post + 1024, p.ffn_pre + 1024, H); break;
    case 15: phase_ffn_up256(sc, p, 1, smem_full); break;
    case 16: phase_gemm_plain256(sc, HID, DFF, (const bf16_t*)(ws + OFF_WT_DN1), DFF, 1024, M, 1024, smem_full); break;
    case 17: phase_resid<1, 0>(XB, p.out, M, p.ffn_post + 1024, nullptr, nullptr); break;
    default: break;
  }
}

#if MEGA
#define BW(i) ((i) * 64)
DI unsigned ba_ld(unsigned* p) { return __hip_atomic_load(p, __ATOMIC_RELAXED, __HIP_MEMORY_SCOPE_AGENT); }
DI unsigned ba_add(unsigned* p, unsigned v) { return __hip_atomic_fetch_add(p, v, __ATOMIC_RELAXED, __HIP_MEMORY_SCOPE_AGENT); }
struct GridBar { unsigned* bar; unsigned x, nloc, nx, k; };
DI void gbar_spin(unsigned* p, unsigned target, unsigned* tmo) {
  unsigned sp = 0;
  while (ba_ld(p) < target) {
    __builtin_amdgcn_s_sleep(1);
    if ((++sp & 1023u) == 0u) { if (ba_ld(tmo)) break; if (sp > (1u << 23)) { ba_add(tmo, 1u); break; } }
  }
}
DI void gbar(GridBar& b) {
  asm volatile("s_waitcnt vmcnt(0)" ::: "memory");
  __syncthreads();
  b.k++;
  if (tid512() == 0) {
    unsigned* bar = b.bar;
    unsigned old = ba_add(&bar[BW(16 + b.x)], 1u);
    if (old + 1u == b.k * b.nloc) {
      __builtin_amdgcn_fence(__ATOMIC_RELEASE, "agent");
      asm volatile("s_waitcnt vmcnt(0)" ::: "memory");
      ba_add(&bar[BW(48)], 1u);
      gbar_spin(&bar[BW(48)], b.k * b.nx, &bar[BW(49)]);
      __hip_atomic_store(&bar[BW(32 + b.x)], b.k, __ATOMIC_RELAXED, __HIP_MEMORY_SCOPE_AGENT);
    } else {
      gbar_spin(&bar[BW(32 + b.x)], b.k, &bar[BW(49)]);
    }
    __builtin_amdgcn_fence(__ATOMIC_ACQUIRE, "agent");
    asm volatile("s_waitcnt vmcnt(0)" ::: "memory");
  }
  __syncthreads();
}
template <int PH>
DI void mega_phases(const Sched& sc, const Params& p, char* smem, GridBar& gb) {
  if constexpr (PH == 7 || PH == 16) { ffn_fixup(p, PH == 16 ? 1 : 0); gbar(gb); }
  run_phase(sc, p, PH, smem);
  if constexpr (((DUP_MASK >> PH) & 1) != 0) { gbar(gb); run_phase(sc, p, PH, smem); }
  if constexpr (PH + 1 < NPHASE) { gbar(gb); if (DUP_SYNC) gbar(gb); mega_phases<PH + 1>(sc, p, smem, gb); }
}
__global__ void __launch_bounds__(512, 2) k_mega(Params p) {
  __shared__ __attribute__((aligned(16))) char smem[SMEM_TOTAL];
  cg::grid_group grid = cg::this_grid();
  GridBar gb;
  gb.bar = (unsigned*)(p.ws + OFF_BAR);
  gb.x = (unsigned)__builtin_amdgcn_s_getreg((3 << 11) | 20) & 0xFu;
  gb.k = 0;
  __shared__ int s_rank;
  if (tid512() == 0) s_rank = (int)ba_add(&gb.bar[BW(gb.x)], 1u);
  Sched sc{0, 1, 0, 1};
  run_phase(sc, p, 0, smem);
  grid.sync();
  {
    unsigned nx = 0, xs = 0, minloc = 0xffffffffu;
    for (int j = 0; j < 16; ++j) {
      unsigned c = ba_ld(&gb.bar[BW(j)]);
      if (c != 0u) { nx++; if ((unsigned)j < gb.x) xs++; minloc = c < minloc ? c : minloc; }
    }
    gb.nx = nx; gb.nloc = ba_ld(&gb.bar[BW(gb.x)]);
    sc.xs = (int)xs; sc.nx = (int)nx; sc.minloc = (int)minloc; sc.rank = __builtin_amdgcn_readfirstlane(s_rank);
  }
  mega_phases<1>(sc, p, smem, gb);
}
#endif

template <int PH>
__global__ void __launch_bounds__(512, 2) k_phase(Params p) {
  __shared__ __attribute__((aligned(16))) char smem[SMEM_TOTAL];
  Sched sc{(int)(blockIdx.x & 7), 8, (int)(blockIdx.x >> 3), (int)(gridDim.x >> 3)};
  if constexpr (PH == 7 || PH == 16) { ffn_fixup(p, PH == 16 ? 1 : 0); __threadfence(); }
  run_phase(sc, p, PH, smem);
}
template <int PH>
static void launch_phases(const Params& p, hipStream_t stream) {
  hipLaunchKernelGGL(k_phase<PH>, dim3(256), dim3(512), 0, stream, p);
  if constexpr (PH + 1 < NPHASE) launch_phases<PH + 1>(p, stream);
}

extern "C" void kernel_launch(void* const* d_in, const int* in_sizes, int n_in, void* d_out, int out_size, void* d_ws, size_t ws_size,
                              hipStream_t stream) {
  Params p{};
  const float** f = (const float**)&p;
  for (int i = 0; i < 30; ++i) f[i] = (const float*)d_in[i];
  p.out = (float*)d_out;
  p.ws = (char*)d_ws;
  p.hbuf = (char*)d_out + (size_t)T * 1024 * 2;
#if MEGA
  static int grid_blocks = 0;
  if (!grid_blocks) {
    int dev = 0, cus = 0, per_cu = 0;
    hipGetDevice(&dev);
    hipDeviceGetAttribute(&cus, hipDeviceAttributeMultiprocessorCount, dev);
    hipOccupancyMaxActiveBlocksPerMultiprocessor(&per_cu, k_mega, 512, 0);
    if (per_cu > 1) per_cu = 1;
    grid_blocks = cus * per_cu;
  }
  hipMemsetAsync((char*)d_ws + OFF_BAR, 0, BAR_BYTES, stream);
  void* args[] = {&p};
  hipError_t e = hipLaunchCooperativeKernel((void*)k_mega, dim3(grid_blocks), dim3(512), args, 0, stream);
  if (e != hipSuccess) fprintf(stderr, "cooperative launch failed: %s (grid %d)\n", hipGetErrorString(e), grid_blocks);
#else
  launch_phases<0>(p, stream);
#endif
}
```
